# Optimizing an MI355X kernel written in HIP

```python
import jax, jax.numpy as jnp
from jax import lax
import numpy as np

D_MODEL = 1024
BATCH = 2
SEQ = 8192
DEPTH = 1

HEAD_DIM = 64
D_MIX = D_MODEL
SWA_WIDTH = D_MIX // 2
SWA_Q_HEADS = SWA_WIDTH // HEAD_DIM
SWA_KV_HEADS = 2
SWA_GROUP = SWA_Q_HEADS // SWA_KV_HEADS
DSA_WIDTH = D_MIX - SWA_WIDTH
DSA_Q_HEADS = DSA_WIDTH // HEAD_DIM
IDX_HEADS = 4
IDX_DIM = 64
WINDOW = 128
BLOCK = 128
TOPK_MAX = 256
ROPE_THETA = 10000.0
LN_EPS = 1e-5
ALPHA = (2.0 * DEPTH) ** 0.25
BETA = (8.0 * DEPTH) ** -0.25
COLUMN_SIZES = (
    SWA_Q_HEADS * HEAD_DIM,
    SWA_KV_HEADS * HEAD_DIM,
    SWA_KV_HEADS * HEAD_DIM,
    SWA_WIDTH,
    DSA_Q_HEADS * HEAD_DIM,
    HEAD_DIM,
    HEAD_DIM,
    DSA_WIDTH,
    IDX_HEADS * IDX_DIM,
    IDX_DIM,
    IDX_HEADS,
)
VALUE_COLUMNS = (2, 6)
N_COLS = sum(COLUMN_SIZES)

kernel_name = "hybrid_swa_sink_dsa_deepnorm_layer"


def rope(x, pos):
    d = x.shape[-1]
    inv = ROPE_THETA ** (-jnp.arange(0, d, 2, dtype=jnp.float32) / d)
    ang = pos.astype(jnp.float32)[:, :, None, None] * inv
    cos, sin = jnp.cos(ang), jnp.sin(ang)
    x1, x2 = jnp.split(x.astype(jnp.float32), 2, axis=-1)
    return jnp.concatenate([x1 * cos - x2 * sin, x2 * cos + x1 * sin], axis=-1).astype(x.dtype)


def layer_norm(x, g, b):
    xf = x.astype(jnp.float32)
    mu = jnp.mean(xf, axis=-1, keepdims=True)
    var = jnp.mean(jnp.square(xf - mu), axis=-1, keepdims=True)
    y = (xf - mu) * lax.rsqrt(var + LN_EPS) * g.astype(jnp.float32) + b.astype(jnp.float32)
    return y.astype(x.dtype)


def sliding_window_sink_attention(q, k, v, sinks):
    b, s, _, d = q.shape
    nb = s // BLOCK
    qb = q.reshape(b, nb, BLOCK, SWA_KV_HEADS, SWA_GROUP, d)

    def with_prev(t):
        t = t.reshape(b, nb, BLOCK, SWA_KV_HEADS, d)
        prev = jnp.pad(t[:, :-1], ((0, 0), (1, 0), (0, 0), (0, 0), (0, 0)))
        return jnp.concatenate([prev, t], axis=2)

    kk, vv = with_prev(k), with_prev(v)
    logits = jnp.einsum('bnqgrd,bnkgd->bngrqk', qb, kk).astype(jnp.float32) * (d ** -0.5)
    blk = jnp.arange(nb)[:, None, None]
    qpos = blk * BLOCK + jnp.arange(BLOCK)[None, :, None]
    kpos = (blk - 1) * BLOCK + jnp.arange(2 * BLOCK)[None, None, :]
    rel = qpos - kpos
    mask = (rel >= 0) & (rel < WINDOW) & (kpos >= 0)
    logits = jnp.where(mask[None, :, None, None], logits, -jnp.inf)
    sink = jnp.broadcast_to(
        sinks.astype(jnp.float32).reshape(SWA_KV_HEADS, SWA_GROUP)[None, None, :, :, None, None],
        logits.shape[:-1] + (1,))
    probs = jax.nn.softmax(jnp.concatenate([logits, sink], axis=-1), axis=-1)[..., :-1]
    out = jnp.einsum('bngrqk,bnkgd->bnqgrd', probs.astype(v.dtype), vv)
    return out.reshape(b, s, SWA_Q_HEADS * d)


def dsa_sparse_attention(q, k, v, q_idx, k_idx, w_idx):
    b, s, h, d = q.shape
    n_sel = min(TOPK_MAX, s // 4)
    nb = s // BLOCK
    key_pos = jnp.arange(s)

    def to_blocks(t):
        return jnp.moveaxis(t.reshape((b, nb, BLOCK) + t.shape[2:]), 1, 0)

    def one_block(args):
        qb, qib, wb, tpos = args
        rel = jax.nn.relu(jnp.einsum('bqhd,bsd->bqhs', qib, k_idx).astype(jnp.float32))
        score = jnp.einsum('bqhs,bqh->bqs', rel, wb.astype(jnp.float32))
        causal = key_pos[None, :] <= tpos[:, None]
        score = jnp.where(causal[None], score, -jnp.inf)
        _, idx = lax.top_k(score, n_sel)
        k_sel = jax.vmap(lambda kk, ii: kk[ii])(k, idx)
        v_sel = jax.vmap(lambda vv, ii: vv[ii])(v, idx)
        logits = jnp.einsum('bqhd,bqkd->bhqk', qb, k_sel).astype(jnp.float32) * (d ** -0.5)
        valid = idx <= tpos[None, :, None]
        logits = jnp.where(valid[:, None], logits, -jnp.inf)
        p = jax.nn.softmax(logits, axis=-1).astype(v.dtype)
        return jnp.einsum('bhqk,bqkd->bqhd', p, v_sel)

    qpos = jnp.arange(s).reshape(nb, BLOCK)
    out = lax.map(one_block, (to_blocks(q), to_blocks(q_idx), to_blocks(w_idx), qpos))
    return jnp.moveaxis(out, 0, 1).reshape(b, s, h * d)


def hybrid_layer(x, positions, w_in, b_in, sinks, w_out, b_out, ln_gain, ln_bias):
    b, s, _ = x.shape
    hcat = jnp.einsum('bsd,dc->bsc', x, w_in) + b_in
    splits = np.cumsum(COLUMN_SIZES)[:-1].tolist()
    aq, ak, av, ag, bq, bk, bv, bg, iq, ik, iw = jnp.split(hcat, splits, axis=-1)
    aq = rope(aq.reshape(b, s, SWA_Q_HEADS, HEAD_DIM), positions)
    ak = rope(ak.reshape(b, s, SWA_KV_HEADS, HEAD_DIM), positions)
    av = av.reshape(b, s, SWA_KV_HEADS, HEAD_DIM)
    a_out = sliding_window_sink_attention(aq, ak, av, sinks) * jax.nn.silu(ag)
    bq = rope(bq.reshape(b, s, DSA_Q_HEADS, HEAD_DIM), positions)
    bk = rope(bk.reshape(b, s, 1, HEAD_DIM), positions)[:, :, 0]
    iq = rope(iq.reshape(b, s, IDX_HEADS, IDX_DIM), positions)
    ik = rope(ik.reshape(b, s, 1, IDX_DIM), positions)[:, :, 0]
    iw = iw * (IDX_HEADS ** -0.5 * IDX_DIM ** -0.5)
    b_mix = dsa_sparse_attention(bq, bk, bv, iq, ik, iw) * jax.nn.silu(bg)
    y = jnp.einsum('bsc,cd->bsd', jnp.concatenate([a_out, b_mix], axis=-1), w_out) + b_out
    return layer_norm(ALPHA * x + y, ln_gain, ln_bias)


def setup_inputs(seed: int = 0) -> dict:
    key = jax.random.key(seed)
    ks = jax.random.split(key, 9)
    x = jax.random.normal(ks[0], (BATCH, SEQ, D_MODEL), jnp.float32)
    positions = jnp.broadcast_to(jnp.arange(SEQ, dtype=jnp.int32), (BATCH, SEQ))
    col_scale = jnp.concatenate([
        jnp.full((n,), BETA if i in VALUE_COLUMNS else 1.0, jnp.float32)
        for i, n in enumerate(COLUMN_SIZES)])
    w_in = jax.random.normal(ks[1], (DEPTH, D_MODEL, N_COLS), jnp.float32) * (D_MODEL ** -0.5) * col_scale
    b_in = 0.02 * jax.random.normal(ks[2], (DEPTH, N_COLS), jnp.float32)
    swa_sinks = jax.random.normal(ks[3], (DEPTH, SWA_Q_HEADS), jnp.float32)
    w_out = jax.random.normal(ks[4], (DEPTH, D_MIX, D_MODEL), jnp.float32) * (D_MIX ** -0.5) * BETA
    b_out = 0.02 * jax.random.normal(ks[5], (DEPTH, D_MODEL), jnp.float32)
    ln_gain = 1.0 + 0.02 * jax.random.normal(ks[6], (DEPTH, D_MODEL), jnp.float32)
    ln_bias = 0.02 * jax.random.normal(ks[7], (DEPTH, D_MODEL), jnp.float32)
    return {"x": x, "positions": positions, "w_in": w_in, "b_in": b_in,
            "swa_sinks": swa_sinks, "w_out": w_out, "b_out": b_out,
            "ln_gain": ln_gain, "ln_bias": ln_bias}


def reference(x, positions, w_in, b_in, swa_sinks, w_out, b_out, ln_gain, ln_bias):
    h = x
    for layer in range(DEPTH):
        h = hybrid_layer(h, positions, w_in[layer], b_in[layer], swa_sinks[layer],
                         w_out[layer], b_out[layer], ln_gain[layer], ln_bias[layer])
    return h
```

```cpp
#include <hip/hip_runtime.h>
#include <hip/hip_cooperative_groups.h>
#include <cstdio>
#include <cstdint>
namespace cg = cooperative_groups;
namespace pg8 {
#define PG8_LAS __attribute__((address_space(3)))
typedef unsigned short bf16_t;
typedef short bf16x8 __attribute__((ext_vector_type(8)));
typedef float f32x4 __attribute__((ext_vector_type(4)));
typedef unsigned u32x4 __attribute__((ext_vector_type(4)));
constexpr int BM = 256, BK = 64, HALF = 128, HTB = HALF * BK * 2  , STAGE_BYTES = 8 * HTB, NXCD = 8, WGM = 8;

__host__ __device__ __forceinline__ int lds_byte(int r, int c) { const int st = (r >> 4) * 2 + (c >> 5), rr = r & 15, cc = c & 31, ob = rr * 64 + cc * 2; return st * 1024 + (ob ^ (((ob >> 9) & 1) << 5)); }
__host__ __device__ __forceinline__ void stage_rc(int b, int& R, int& C) { const int st = b / 1024, sb = b % 1024, swz = sb ^ (((sb >> 9) & 1) << 5); R = (st >> 1) * 16 + swz / 64; C = (st & 1) * 32 + (swz % 64) / 2; }
__host__ __device__ __forceinline__ int perm32(int rho) { const int n = rho >> 4, i = rho & 15; return 8 * (i >> 2) + 4 * n + (i & 3); }

struct Unit { int pm, pn; };
struct Gemm { const bf16_t* A; const bf16_t* Bt; int M, N, K; };

struct StaticOrder {
    int nM, nN, nwg, G, c;
    __host__ __device__ void init(int M, int N, int G_, int c_) { nM = M / BM; nN = N / BM; nwg = nM * nN; G = G_; c = c_; }
    __host__ __device__ bool next(int i, Unit& u) const {
        const long L = (long)i * G + c; if (L >= nwg) return false;
        int wgid = (int)L; { const int q = nwg / NXCD, r = nwg % NXCD, xcd = wgid % NXCD, off = wgid / NXCD; wgid = (xcd < r ? xcd * (q + 1) : r * (q + 1) + (xcd - r) * q) + off; }
        const int nig = WGM * nN, gid = wgid / nig, fm = gid * WGM, gsz = (nM - fm) < WGM ? (nM - fm) : WGM;
        u.pm = fm + ((wgid % nig) % gsz); u.pn = (wgid % nig) / gsz; return true;
    }
    __device__ __forceinline__ void a_ready(const Unit&) const {}
    __device__ __forceinline__ void done(const Unit&) const {}
};

__device__ __forceinline__ unsigned cvt_pk_bf16(float lo, float hi) { unsigned r; asm volatile("v_cvt_pk_bf16_f32 %0, %1, %2" : "=v"(r) : "v"(lo), "v"(hi)); return r; }
template <class Epi, class Sched, bool ALIGN_EPI = false, bool SP2 = false>
__device__ __forceinline__ void gemm_phase(PG8_LAS unsigned char* lds, const Gemm g, const Sched& S, const Epi& E) {
    const int tid = threadIdx.x, wid = __builtin_amdgcn_readfirstlane(tid >> 6), lane = tid & 63, wr = wid >> 2, wc = wid & 3, fr = lane & 15, fq = lane >> 4;
    const int K = g.K, nt = K / BK;
    unsigned voffA[2], voffB[2];
#pragma unroll
    for (int i = 0; i < 2; ++i) { int R, C; stage_rc(tid * 16 + i * 8192, R, C); const int Rb = Epi::PERM ? ((R & ~31) + perm32(R & 31)) : R;
        voffA[i] = (unsigned)(R * K + C) * 2u; voffB[i] = (unsigned)(Rb * K + C) * 2u; }
    const size_t kstep = (size_t)(BK * 2);
    const size_t hstep = (size_t)HALF * K * 2;
    const size_t tstep = 2 * hstep;
    const unsigned ldsw = (unsigned)wid * 1024u;
    const int aoff = lds_byte(wr * 64 + fr, fq * 8), boff = lds_byte(wc * 32 + fr, fq * 8);
#define PG8_SA(b, h) (((b) * 2 + (h)) * HTB)
#define PG8_SB(b, h) ((4 + (b) * 2 + (h)) * HTB)
#define PG8_STAGE(bufoff, gbase, voff) do { _Pragma("unroll") for (int _i = 0; _i < 2; ++_i) \
        __builtin_amdgcn_global_load_lds((const unsigned*)((const char*)(gbase) + (voff)[_i]), (PG8_LAS unsigned*)(lds + (bufoff) + ldsw + _i * 8192), 16, 0, 0); } while (0)
#define PG8_LDA(dst, b, h) do { _Pragma("unroll") for (int m = 0; m < 4; ++m) _Pragma("unroll") for (int k = 0; k < 2; ++k) dst[m][k] = *(const PG8_LAS bf16x8*)(lds + PG8_SA(b, h) + aoff + m * 2048 + k * 1024); } while (0)
#define PG8_LDB(dst, b, h) do { _Pragma("unroll") for (int n = 0; n < 2; ++n) _Pragma("unroll") for (int k = 0; k < 2; ++k) dst[n][k] = *(const PG8_LAS bf16x8*)(lds + PG8_SB(b, h) + boff + n * 2048 + k * 1024); } while (0)
#define PG8_MMA(ai, bj, At, Bt) do { __builtin_amdgcn_s_setprio(1); _Pragma("unroll") for (int m = 0; m < 4; ++m) _Pragma("unroll") for (int n = 0; n < 2; ++n) _Pragma("unroll") for (int k = 0; k < 2; ++k) \
        acc[ai][bj][m][n] = __builtin_amdgcn_mfma_f32_16x16x32_bf16(Bt[n][k], At[m][k], acc[ai][bj][m][n], 0, 0, 0); __builtin_amdgcn_s_setprio(0); } while (0)
#define PG8_WAIT_V(n) asm volatile("s_waitcnt vmcnt(" #n ")" ::: "memory")
#define PG8_WAIT_L(n) asm volatile("s_waitcnt lgkmcnt(" #n ")" ::: "memory")
#define PG8_BAR __builtin_amdgcn_s_barrier()
#define PG8_SCHED __builtin_amdgcn_sched_barrier(0)
    Unit cur, nxt; int ui = 0;
    if (!S.next(0, cur)) return;
    f32x4 acc[2][2][4][2];
#pragma unroll
    for (int a = 0; a < 2; ++a)
#pragma unroll
        for (int b = 0; b < 2; ++b)
#pragma unroll
            for (int m = 0; m < 4; ++m)
#pragma unroll
                for (int n = 0; n < 2; ++n) acc[a][b][m][n] = (f32x4){0.f, 0.f, 0.f, 0.f};
    bf16x8 At[4][2], B0[2][2], B1[2][2];
    const char* cA = (const char*)g.A + (size_t)cur.pm * tstep; const char* cB = (const char*)g.Bt + (size_t)cur.pn * tstep;
    S.a_ready(cur);
    if constexpr (SP2) {
        PG8_STAGE(PG8_SB(0, 0), cB, voffB); PG8_STAGE(PG8_SB(0, 1), cB + hstep, voffB); PG8_STAGE(PG8_SA(0, 0), cA, voffA); PG8_STAGE(PG8_SA(0, 1), cA + hstep, voffA);
        if (wr == 1) PG8_BAR;
        PG8_WAIT_V(2); PG8_BAR;
        PG8_STAGE(PG8_SB(1, 0), cB + kstep, voffB); PG8_STAGE(PG8_SA(1, 0), cA + kstep, voffA); PG8_STAGE(PG8_SB(1, 1), cB + hstep + kstep, voffB);
        PG8_WAIT_V(6); PG8_BAR;
    } else {
        PG8_STAGE(PG8_SB(0, 0), cB, voffB); PG8_STAGE(PG8_SA(0, 0), cA, voffA); PG8_STAGE(PG8_SB(0, 1), cB + hstep, voffB); PG8_STAGE(PG8_SA(0, 1), cA + hstep, voffA);
        if (wr == 1) PG8_BAR;
        PG8_WAIT_V(4); PG8_BAR;
        PG8_STAGE(PG8_SB(1, 0), cB + kstep, voffB); PG8_STAGE(PG8_SA(1, 0), cA + kstep, voffA); PG8_STAGE(PG8_SB(1, 1), cB + hstep + kstep, voffB);
        PG8_WAIT_V(6); PG8_BAR;
    }
    for (;;) {
        const bool has_next = S.next(ui + 1, nxt);
        const char* nA = has_next ? (const char*)g.A + (size_t)nxt.pm * tstep : cA; const char* nB = has_next ? (const char*)g.Bt + (size_t)nxt.pn * tstep : cB;
        for (int t = 0; t < nt; t += 2) {
            const bool last = (t == nt - 2);
            const char* a1 = cA + (size_t)(t + 1) * kstep;
            const char* a2 = last ? nA : cA + (size_t)(t + 2) * kstep; const char* b2 = last ? nB : cB + (size_t)(t + 2) * kstep;
            const char* a3 = a2 + kstep; const char* b3 = b2 + kstep;
            if (last && has_next) S.a_ready(nxt);
            if constexpr (SP2) {
            PG8_LDB(B0, 0, 0); PG8_LDB(B1, 0, 1); PG8_SCHED; PG8_LDA(At, 0, 0); PG8_STAGE(PG8_SA(1, 1), a1 + hstep, voffA);
            PG8_WAIT_V(8); PG8_WAIT_L(0); PG8_BAR; PG8_MMA(0, 0, At, B0); PG8_MMA(0, 1, At, B1); PG8_BAR; PG8_SCHED;
            PG8_LDA(At, 0, 1); PG8_STAGE(PG8_SB(0, 0), b2, voffB); PG8_STAGE(PG8_SB(0, 1), b2 + hstep, voffB); PG8_STAGE(PG8_SA(0, 0), a2, voffA);
            PG8_WAIT_V(8); PG8_WAIT_L(0); PG8_BAR; PG8_MMA(1, 0, At, B0); PG8_MMA(1, 1, At, B1); PG8_BAR; PG8_SCHED;
            PG8_LDB(B0, 1, 0); PG8_LDB(B1, 1, 1); PG8_SCHED; PG8_LDA(At, 1, 0); PG8_STAGE(PG8_SA(0, 1), a2 + hstep, voffA);
            PG8_WAIT_V(8); PG8_WAIT_L(0); PG8_BAR; PG8_MMA(0, 0, At, B0); PG8_MMA(0, 1, At, B1); PG8_BAR; PG8_SCHED;
            PG8_LDA(At, 1, 1); PG8_STAGE(PG8_SB(1, 0), b3, voffB); PG8_STAGE(PG8_SB(1, 1), b3 + hstep, voffB); PG8_STAGE(PG8_SA(1, 0), a3, voffA);
            PG8_WAIT_V(8); PG8_WAIT_L(0); PG8_BAR; PG8_MMA(1, 0, At, B0); PG8_MMA(1, 1, At, B1); PG8_BAR; PG8_SCHED;
            } else {
            PG8_LDB(B0, 0, 0); PG8_SCHED; PG8_LDA(At, 0, 0); PG8_STAGE(PG8_SA(1, 1), a1 + hstep, voffA);
            PG8_WAIT_L(8); PG8_BAR; PG8_WAIT_L(0); PG8_MMA(0, 0, At, B0); PG8_BAR; PG8_SCHED;
            PG8_LDB(B1, 0, 1); PG8_STAGE(PG8_SB(0, 0), b2, voffB);
            PG8_BAR; PG8_WAIT_L(0); PG8_MMA(0, 1, At, B1); PG8_BAR;
            PG8_LDA(At, 0, 1); PG8_STAGE(PG8_SA(0, 0), a2, voffA);
            PG8_BAR; PG8_WAIT_L(0); PG8_MMA(1, 0, At, B0); PG8_BAR; PG8_SCHED;
            PG8_STAGE(PG8_SB(0, 1), b2 + hstep, voffB);
            PG8_WAIT_V(6); PG8_BAR; PG8_MMA(1, 1, At, B1); PG8_BAR;
            PG8_LDB(B0, 1, 0); PG8_SCHED; PG8_LDA(At, 1, 0); PG8_STAGE(PG8_SA(0, 1), a2 + hstep, voffA);
            PG8_WAIT_L(8); PG8_BAR; PG8_WAIT_L(0); PG8_MMA(0, 0, At, B0); PG8_BAR; PG8_SCHED;
            PG8_LDB(B1, 1, 1); PG8_STAGE(PG8_SB(1, 0), b3, voffB);
            PG8_BAR; PG8_WAIT_L(0); PG8_MMA(0, 1, At, B1); PG8_BAR;
            PG8_LDA(At, 1, 1); PG8_STAGE(PG8_SA(1, 0), a3, voffA);
            PG8_BAR; PG8_WAIT_L(0); PG8_MMA(1, 0, At, B0); PG8_BAR; PG8_SCHED;
            PG8_STAGE(PG8_SB(1, 1), b3 + hstep, voffB);
            PG8_WAIT_V(6); PG8_BAR; PG8_MMA(1, 1, At, B1); PG8_BAR;
            }
        }
        if constexpr (ALIGN_EPI) { if (wr == 0) PG8_BAR; }
        if constexpr (!Epi::AFTER_DRAIN) { E(acc, cur, wr, wc, fr, fq); S.done(cur); }
        if (!has_next) break;
#pragma unroll
        for (int a = 0; a < 2; ++a)
#pragma unroll
            for (int b = 0; b < 2; ++b)
#pragma unroll
                for (int m = 0; m < 4; ++m)
#pragma unroll
                    for (int n = 0; n < 2; ++n) acc[a][b][m][n] = (f32x4){0.f, 0.f, 0.f, 0.f};
        cur = nxt; cA = nA; cB = nB; ++ui;
        if constexpr (ALIGN_EPI) { if (wr == 1) PG8_BAR; }
    }
    PG8_WAIT_V(0);
    if constexpr (!ALIGN_EPI) { if (wr == 0) PG8_BAR; }
    PG8_BAR;
    if constexpr (Epi::AFTER_DRAIN) { E.fused(acc, cur, wr, wc, fr, fq, lds, wid, lane); S.done(cur); }
#undef PG8_SA
#undef PG8_SB
#undef PG8_STAGE
#undef PG8_LDA
#undef PG8_LDB
#undef PG8_MMA
#undef PG8_WAIT_V
#undef PG8_WAIT_L
#undef PG8_BAR
#undef PG8_SCHED
}
}
#define LAS __attribute__((address_space(3)))
typedef unsigned short bf16_t;
typedef short bf16x8 __attribute__((ext_vector_type(8)));
typedef short s16x4 __attribute__((ext_vector_type(4)));
typedef float f32x4 __attribute__((ext_vector_type(4)));
typedef float f32x2 __attribute__((ext_vector_type(2)));
typedef float f32x16 __attribute__((ext_vector_type(16)));
typedef unsigned u32x4 __attribute__((ext_vector_type(4)));
typedef unsigned u32x2 __attribute__((ext_vector_type(2)));
using pg8::cvt_pk_bf16;

constexpr int SEQ = 8192, NB = 2, M = NB * SEQ, DM = 1024, NCOL = 2756, NPAD = 2816, HP = 2752;
constexpr int C_AQ = 0, C_AK = 512, C_AV = 640, C_AG = 768, C_BQ = 1280, C_BK = 1792, C_BV = 1856, C_BG = 1920, C_IQ = 2432, C_IK = 2688, C_IW = 2752;
constexpr float LOG2E = 1.4426950408889634f, QSCALE = 0.125f * LOG2E, LN_EPS = 1e-5f;
constexpr float ALPHA = 1.189207115002721f;
constexpr size_t MiB = 1u << 20;
constexpr size_t WS_CTL = 0, WS_BTIN = 2 * MiB, WS_BTOUT = 8 * MiB, WS_CS = 10 * MiB, WS_IW = 14 * MiB, WS_NSEL = 15 * MiB, WS_SEL = 16 * MiB,
                 WS_XN = 24 * MiB, WS_H = 56 * MiB, WS_MIX = 142 * MiB, WS_YPRE = 174 * MiB, WS_END = 238 * MiB;
constexpr int LDS_BYTES = 147456;
constexpr int NTHREADS = 512, NWAVES = 8;
#define MFMA32(a, b, c) __builtin_amdgcn_mfma_f32_32x32x16_bf16((a), (b), (c), 0, 0, 0)
#define LDSWAIT() asm volatile("s_waitcnt lgkmcnt(0)" ::: "memory")

__device__ __forceinline__ int crow(int i, int h) { return (i & 3) + 8 * (i >> 2) + 4 * h; }
__device__ __forceinline__ int swap45(int c) { return (c & ~48) | ((c & 16) << 1) | ((c & 32) >> 1); }
__device__ __forceinline__ float bf2f(unsigned short b) { return __uint_as_float((unsigned)b << 16); }
__device__ __forceinline__ bf16x8 ldg16(const bf16_t* p) { return *(const bf16x8*)p; }
__device__ __forceinline__ bf16x8 pack8(const f32x16& x, int s) {
  u32x4 p; p.x = cvt_pk_bf16(x[8 * s + 0], x[8 * s + 1]); p.y = cvt_pk_bf16(x[8 * s + 2], x[8 * s + 3]); p.z = cvt_pk_bf16(x[8 * s + 4], x[8 * s + 5]); p.w = cvt_pk_bf16(x[8 * s + 6], x[8 * s + 7]);
  return __builtin_bit_cast(bf16x8, p);
}
__device__ __forceinline__ s16x4 tr_read(LAS unsigned char* p) { return __builtin_amdgcn_ds_read_tr16_b64_v4i16((LAS s16x4*)p); }

struct Args { const float* x; const int* pos; const float* w_in; const float* b_in; const float* sinks; const float* w_out; const float* b_out; const float* ln_g; const float* ln_b;
              float* out; unsigned char* ws; };

__device__ __forceinline__ void p0_transpose_item(const float* W, int N, bf16_t* WT, bool perm, LAS float* scr, int item, int nblk, int lane) {
  const int kb = item / nblk, nb = item % nblk, k0 = 64 * kb, n0 = 32 * nb;
  const int nn = n0 + (lane & 31);
#pragma unroll 8
  for (int i = 0; i < 32; ++i) { const int kk = 2 * i + (lane >> 5); scr[kk * 33 + (lane & 31)] = nn < N ? W[(size_t)(k0 + kk) * N + nn] : 0.f; }
  LDSWAIT();
  const int c = lane & 7;
#pragma unroll
  for (int j = 0; j < 4; ++j) { const int n = (lane >> 3) + 8 * j; const LAS float* s = scr + (8 * c) * 33 + n;
    u32x4 o; o.x = cvt_pk_bf16(s[0 * 33], s[1 * 33]); o.y = cvt_pk_bf16(s[2 * 33], s[3 * 33]); o.z = cvt_pk_bf16(s[4 * 33], s[5 * 33]); o.w = cvt_pk_bf16(s[6 * 33], s[7 * 33]);
    const int grow = perm ? swap45(n0 + n) : (n0 + n);
    *(u32x4*)(WT + (size_t)grow * 1024 + k0 + 8 * c) = o; }
  LDSWAIT();
}
__device__ __forceinline__ void p0_prologue(const Args& a, LAS unsigned char* lds) {
  const int tid = threadIdx.x, lane = tid & 63, wid = tid >> 6;
  const int gw = blockIdx.x * NWAVES + wid, NGW = gridDim.x * NWAVES;
  LAS float* scr = (LAS float*)(lds + wid * 16384);
  bf16_t* BTIN = (bf16_t*)(a.ws + WS_BTIN); bf16_t* BTOUT = (bf16_t*)(a.ws + WS_BTOUT);
  constexpr int NBI = NPAD / 32, I_IN = 16 * NBI, I_OUT = 16 * 32;
  for (int it = gw; it < I_IN + I_OUT; it += NGW) {
    if (it < I_IN) p0_transpose_item(a.w_in, NCOL, BTIN, true, scr, it, NBI, lane);
    else p0_transpose_item(a.w_out, DM, BTOUT, false, scr, it - I_IN, 32, lane);
  }
  const int gt = blockIdx.x * NTHREADS + tid, NGT = gridDim.x * NTHREADS;
  bf16_t* XN = (bf16_t*)(a.ws + WS_XN);
  for (int i = gt; i < M * DM / 8; i += NGT) {
    const f32x4 v0 = *(const f32x4*)(a.x + (size_t)i * 8), v1 = *(const f32x4*)(a.x + (size_t)i * 8 + 4);
    u32x4 o; o.x = cvt_pk_bf16(v0[0], v0[1]); o.y = cvt_pk_bf16(v0[2], v0[3]); o.z = cvt_pk_bf16(v1[0], v1[1]); o.w = cvt_pk_bf16(v1[2], v1[3]);
    *(u32x4*)(XN + (size_t)i * 8) = o;
  }
  f32x2* CS = (f32x2*)(a.ws + WS_CS);
  for (int i = gt; i < M * 32; i += NGT) {
    const int row = i >> 5, j = i & 31;
    const float inv = exp2f(-(float)j * (13.287712379549449f / 32.0f));
    const float ang = (float)a.pos[row] * inv;
    CS[i] = (f32x2){cosf(ang), sinf(ang)};
  }
}

struct EpiInProj {
  static constexpr bool PERM = false, AFTER_DRAIN = false;
  bf16_t* H; float* IW; const float* bias; const f32x2* CS;
  __device__ __forceinline__ void operator()(const f32x4 (&acc)[2][2][4][2], const pg8::Unit& u, int wr, int wc, int fr, int fq) const {
    const int row0 = u.pm * 256 + wr * 64 + fr;
    const int dloc = 16 * (wc & 1) + 4 * fq;
#pragma unroll
    for (int bj = 0; bj < 2; ++bj) {
      const int G = 4 * u.pn + 2 * bj + (wc >> 1);
      if (G >= 44) continue;
      const int col1 = 64 * G + dloc;
      if (G == 43) {
        if (dloc == 0) {
          const f32x4 b1 = *(const f32x4*)(bias + col1);
#pragma unroll
          for (int ai = 0; ai < 2; ++ai)
#pragma unroll
            for (int m = 0; m < 4; ++m) { const int row = row0 + 128 * ai + 16 * m; *(f32x4*)(IW + (size_t)row * 4) = (acc[ai][bj][m][0] + b1) * 0.0625f; }
        }
        continue;
      }
      const f32x4 b1 = *(const f32x4*)(bias + col1), b2 = *(const f32x4*)(bias + col1 + 32);
      const bool rope = (G < 10) || (G >= 20 && G < 29) || (G >= 38);
      const bool silu = (G >= 12 && G < 20) || (G >= 30 && G < 38);
      const float sc = ((G < 8) || (G >= 20 && G < 28)) ? QSCALE : 1.0f;
#pragma unroll
      for (int ai = 0; ai < 2; ++ai)
#pragma unroll
        for (int m = 0; m < 4; ++m) {
          const int row = row0 + 128 * ai + 16 * m;
          f32x4 v1 = acc[ai][bj][m][0] + b1, v2 = acc[ai][bj][m][1] + b2;
          if (rope) {
            const f32x4 cs0 = *(const f32x4*)((const float*)CS + ((size_t)row * 32 + dloc) * 2), cs1 = *(const f32x4*)((const float*)CS + ((size_t)row * 32 + dloc) * 2 + 4);
            const f32x4 c = {cs0[0], cs0[2], cs1[0], cs1[2]}, s = {cs0[1], cs0[3], cs1[1], cs1[3]};
            const f32x4 o1 = v1 * c - v2 * s, o2 = v2 * c + v1 * s;
            v1 = o1 * sc; v2 = o2 * sc;
          } else if (silu) {
#pragma unroll
            for (int i = 0; i < 4; ++i) { v1[i] = v1[i] / (1.0f + __expf(-v1[i])); v2[i] = v2[i] / (1.0f + __expf(-v2[i])); }
          }
          u32x2 w1, w2; w1.x = cvt_pk_bf16(v1[0], v1[1]); w1.y = cvt_pk_bf16(v1[2], v1[3]); w2.x = cvt_pk_bf16(v2[0], v2[1]); w2.y = cvt_pk_bf16(v2[2], v2[3]);
          bf16_t* p = H + (size_t)row * HP + col1;
          *(u32x2*)p = w1; *(u32x2*)(p + 32) = w2;
        }
    }
  }
};
struct EpiOutProj {
  static constexpr bool PERM = false, AFTER_DRAIN = false;
  float* Y; const float* bias; const float* x;
  __device__ __forceinline__ void operator()(const f32x4 (&acc)[2][2][4][2], const pg8::Unit& u, int wr, int wc, int fr, int fq) const {
    const int row0 = u.pm * 256 + wr * 64 + fr, col0 = u.pn * 256 + wc * 32 + 4 * fq;
#pragma unroll
    for (int bj = 0; bj < 2; ++bj)
#pragma unroll
      for (int n = 0; n < 2; ++n) { const int col = col0 + 128 * bj + 16 * n; const f32x4 bv = *(const f32x4*)(bias + col);
#pragma unroll
        for (int ai = 0; ai < 2; ++ai)
#pragma unroll
          for (int m = 0; m < 4; ++m) { const size_t off = (size_t)(row0 + 128 * ai + 16 * m) * DM + col;
            *(f32x4*)(Y + off) = acc[ai][bj][m][n] + bv + ALPHA * *(const f32x4*)(x + off); } }
  }
};
__device__ __forceinline__ void swa_unit(LAS unsigned char* lds, int u, const bf16_t* H, const float* sinks, bf16_t* MIX) {
  const int tid = threadIdx.x, lane = tid & 63, wid = __builtin_amdgcn_readfirstlane(tid >> 6), r = lane & 31, h = lane >> 5;
  const int g = u & 1, qb = (u >> 1) & 127, b = u >> 8;
  const size_t rowbase = (size_t)b * SEQ;
  const int t00 = qb * 64, kbase = t00 - 128;
  for (int i = tid; i < 192 * 8; i += NTHREADS) {
    const int kl = i >> 3, piece = i & 7, key = kbase + kl;
    u32x4 v = {0u, 0u, 0u, 0u};
    if (key >= 0) v = *(const u32x4*)(H + (rowbase + key) * HP + C_AV + g * 64 + piece * 8);
    *(LAS u32x4*)(lds + kl * 128 + piece * 16) = v;
  }
  __syncthreads();
  const int r4 = wid & 3, sub = wid >> 2, hq = g * 4 + r4, t0 = t00 + 32 * sub;
  bf16x8 Bq[4];
#pragma unroll
  for (int ks = 0; ks < 4; ++ks) Bq[ks] = ldg16(H + (rowbase + t0 + r) * HP + C_AQ + hq * 64 + 16 * ks + 8 * h);
  f32x16 S[5];
#pragma unroll
  for (int tl = 0; tl < 5; ++tl) {
    const int key = t0 - 128 + 32 * tl + r, kc = key < 0 ? 0 : key;
    f32x16 acc;
#pragma unroll
    for (int i = 0; i < 16; ++i) acc[i] = 0.f;
#pragma unroll
    for (int ks = 0; ks < 4; ++ks) { const bf16x8 A = ldg16(H + (rowbase + kc) * HP + C_AK + g * 64 + 16 * ks + 8 * h); acc = MFMA32(A, Bq[ks], acc); }
    S[tl] = acc;
  }
  const float sk = sinks[hq] * LOG2E;
  float mx = sk;
#pragma unroll
  for (int tl = 0; tl < 5; ++tl)
#pragma unroll
    for (int i = 0; i < 16; ++i) {
      const int rel = r + 128 - 32 * tl - crow(i, h), key = t0 + r - rel;
      const bool valid = rel >= 0 && rel < 128 && key >= 0;
      S[tl][i] = valid ? S[tl][i] : -INFINITY;
      mx = fmaxf(mx, S[tl][i]);
    }
  mx = fmaxf(mx, __shfl_xor(mx, 32));
  float sum = 0.f;
#pragma unroll
  for (int tl = 0; tl < 5; ++tl)
#pragma unroll
    for (int i = 0; i < 16; ++i) { const float p = exp2f(S[tl][i] - mx); S[tl][i] = p; sum += p; }
  sum += __shfl_xor(sum, 32);
  sum += exp2f(sk - mx);
  const float rs = 1.0f / sum;
  f32x16 O[2];
#pragma unroll
  for (int dt = 0; dt < 2; ++dt)
#pragma unroll
    for (int i = 0; i < 16; ++i) O[dt][i] = 0.f;
  const int i16 = lane & 15, q4 = i16 >> 2, p4 = i16 & 3, g16 = (lane >> 4) & 1;
  LAS unsigned char* vb = lds + (32 * sub + 4 * h + q4) * 128 + (16 * g16 + 4 * p4) * 2;
#pragma unroll
  for (int tl = 0; tl < 5; ++tl)
#pragma unroll
    for (int s = 0; s < 2; ++s) {
      const bf16x8 P = pack8(S[tl], s);
#pragma unroll
      for (int dt = 0; dt < 2; ++dt) {
        LAS unsigned char* p = vb + (32 * tl + 16 * s) * 128 + dt * 64;
        const s16x4 lo = tr_read(p), hi = tr_read(p + 8 * 128);
        const bf16x8 A2 = __builtin_shufflevector(lo, hi, 0, 1, 2, 3, 4, 5, 6, 7);
        O[dt] = MFMA32(A2, P, O[dt]);
      }
    }
  const size_t row = rowbase + t0 + r;
#pragma unroll
  for (int dt = 0; dt < 2; ++dt)
#pragma unroll
    for (int g4 = 0; g4 < 4; ++g4) {
      const int d = 32 * dt + 8 * g4 + 4 * h;
      const u32x2 gt = *(const u32x2*)(H + row * HP + C_AG + hq * 64 + d);
      const float o0 = O[dt][4 * g4 + 0] * rs * __uint_as_float(gt.x << 16), o1 = O[dt][4 * g4 + 1] * rs * __uint_as_float(gt.x & 0xffff0000u);
      const float o2 = O[dt][4 * g4 + 2] * rs * __uint_as_float(gt.y << 16), o3 = O[dt][4 * g4 + 3] * rs * __uint_as_float(gt.y & 0xffff0000u);
      u32x2 w; w.x = cvt_pk_bf16(o0, o1); w.y = cvt_pk_bf16(o2, o3);
      *(u32x2*)(MIX + row * DM + hq * 64 + d) = w;
    }
  __syncthreads();
}

constexpr int LC = 768, L_SCR = 98304, L_HIST = 135168, L_CNT = 143360, L_TAU = 143488, L_WL = 143616, L_UNIT = 144128;
__device__ __forceinline__ void select_compact(LAS unsigned* L, unsigned n, LAS unsigned* hist, unsigned limit, LAS unsigned* cntp, LAS unsigned* taup, int lane) {
  unsigned prefix = 0u, mask = 0u, kk = 256u;
  for (int p = 0; p < 4; ++p) {
    const int shift = 24 - 8 * p;
    *(LAS u32x4*)(hist + 4 * lane) = (u32x4){0u, 0u, 0u, 0u};
    LDSWAIT();
    for (unsigned i = lane; i < n; i += 64) { const unsigned e = L[i]; if ((e & mask) == prefix) __hip_atomic_fetch_add(hist + ((e >> shift) & 255u), 1u, __ATOMIC_RELAXED, __HIP_MEMORY_SCOPE_WORKGROUP); }
    LDSWAIT();
    const u32x4 hb = *(LAS u32x4*)(hist + 4 * lane);
    const unsigned s4 = hb.x + hb.y + hb.z + hb.w;
    unsigned incl = s4;
#pragma unroll
    for (int o = 1; o < 64; o <<= 1) { const unsigned t = __shfl_down(incl, o); if (lane + o < 64) incl += t; }
    unsigned run = incl - s4;
    bool found = false; unsigned Bl = 0u, abl = 0u, bcl = 0u;
#pragma unroll
    for (int bb = 3; bb >= 0; --bb) { const unsigned c = hb[bb]; if (!found && run < kk && run + c >= kk) { found = true; Bl = 4u * lane + bb; abl = run; bcl = c; } run += c; }
    const unsigned long long fm = __ballot(found);
    const int src = __ffsll((long long)fm) - 1;
    const unsigned B = __shfl(Bl, src), above = __shfl(abl, src), bc = __shfl(bcl, src);
    prefix |= B << shift; mask |= 255u << shift;
    const unsigned kept = (256u - kk) + above + bc;
    kk -= above;
    if (kept <= limit) break;
  }
  unsigned off = 0u;
  for (unsigned base = 0; base < n; base += 64) {
    const unsigned i = base + lane; const unsigned e = (i < n) ? L[i] : 0u; const bool keep = (i < n) && (e >= prefix);
    const unsigned long long km = __ballot(keep);
    const unsigned pos = off + (unsigned)__popcll(km & ((1ull << lane) - 1ull));
    if (keep) L[pos] = e;
    off += (unsigned)__popcll(km);
  }
  if (lane == 0) { *cntp = off; *taup = prefix ? prefix - 1u : 0u; }
  LDSWAIT();
}

__device__ __forceinline__ void indexer_unit(LAS unsigned char* lds, int u, const bf16_t* H, const float* IW, unsigned short* SEL, int* NSEL) {
  const int tid = threadIdx.x, lane = tid & 63, wid = __builtin_amdgcn_readfirstlane(tid >> 6), r = lane & 31, h = lane >> 5;
  const int b = u & 1, qblk = 255 - (u >> 1);
  LAS unsigned* lists = (LAS unsigned*)lds;
  LAS unsigned* scr = (LAS unsigned*)(lds + L_SCR + wid * 4608);
  LAS unsigned* hist = (LAS unsigned*)(lds + L_HIST + wid * 1024);
  LAS unsigned* cnt = (LAS unsigned*)(lds + L_CNT);
  LAS unsigned* tau = (LAS unsigned*)(lds + L_TAU);
  LAS float* wl = (LAS float*)(lds + L_WL);
  const int q0 = qblk * 32; const size_t rowbase = (size_t)b * SEQ;
  if (tid < 32) { cnt[tid] = 0u; tau[tid] = 0u; *(LAS f32x4*)(wl + tid * 4) = *(const f32x4*)(IW + (rowbase + q0 + tid) * 4); }
  bf16x8 Aq[4][4];
#pragma unroll
  for (int rt = 0; rt < 4; ++rt)
#pragma unroll
    for (int ks = 0; ks < 4; ++ks) Aq[rt][ks] = ldg16(H + (rowbase + q0 + 8 * rt + (r >> 2)) * HP + C_IQ + (r & 3) * 64 + 16 * ks + 8 * h);
  __syncthreads();
  const int nch = (q0 + 32 + 255) >> 8;
  unsigned mytau = 0u; const int myq = lane & 31, mykh = lane >> 5;
  for (int c = 0; c < nch; ++c) {
    const int kt0 = c * 256 + wid * 32;
    if (kt0 <= q0 + 31) {
      bf16x8 Bk[4];
#pragma unroll
      for (int ks = 0; ks < 4; ++ks) Bk[ks] = ldg16(H + (rowbase + kt0 + r) * HP + C_IK + 16 * ks + 8 * h);
      const int key = kt0 + r;
#pragma unroll
      for (int rt = 0; rt < 4; ++rt) {
        f32x16 acc;
#pragma unroll
        for (int i = 0; i < 16; ++i) acc[i] = 0.f;
#pragma unroll
        for (int ks = 0; ks < 4; ++ks) acc = MFMA32(Aq[rt][ks], Bk[ks], acc);
#pragma unroll
        for (int g = 0; g < 4; ++g) {
          const int ql = 8 * rt + 2 * g + h;
          const f32x4 w = *(LAS f32x4*)(wl + ql * 4);
          const float s = w[0] * fmaxf(acc[4 * g], 0.f) + w[1] * fmaxf(acc[4 * g + 1], 0.f) + w[2] * fmaxf(acc[4 * g + 2], 0.f) + w[3] * fmaxf(acc[4 * g + 3], 0.f);
          unsigned ub = __float_as_uint(s); ub = (ub & 0x7fffffffu) ? ub : 0u;
          const unsigned ord = ub ^ ((unsigned)((int)ub >> 31) | 0x80000000u);
          unsigned enc = (ord & 0xffffe000u) | (unsigned)(8191 - key);
          if (key > q0 + ql) enc = 0u;
          scr[ql * 36 + r] = enc;
        }
      }
      LDSWAIT();
      u32x4 e[4];
#pragma unroll
      for (int i = 0; i < 4; ++i) e[i] = *(LAS u32x4*)(scr + myq * 36 + mykh * 16 + 4 * i);
      unsigned np = 0u;
#pragma unroll
      for (int i = 0; i < 4; ++i)
#pragma unroll
        for (int j = 0; j < 4; ++j) np += (e[i][j] > mytau) ? 1u : 0u;
      unsigned pos = 0u;
      if (np) pos = __hip_atomic_fetch_add(cnt + myq, np, __ATOMIC_RELAXED, __HIP_MEMORY_SCOPE_WORKGROUP);
      LAS unsigned* lp = lists + myq * LC;
#pragma unroll
      for (int i = 0; i < 4; ++i)
#pragma unroll
        for (int j = 0; j < 4; ++j) { const unsigned ev = e[i][j]; if (ev > mytau) { lp[pos] = ev; ++pos; } }
    }
    __syncthreads();
    const bool last = (c == nch - 1);
    for (int qq = wid; qq < 32; qq += 8) {
      const unsigned n = cnt[qq];
      if (last ? (n > 256u) : (n > (unsigned)(LC - 256))) select_compact(lists + qq * LC, n, hist, last ? 256u : 384u, cnt + qq, tau + qq, lane);
    }
    __syncthreads();
    mytau = tau[myq];
  }
  for (int qq = wid; qq < 32; qq += 8) {
    const unsigned n = cnt[qq]; const size_t row = rowbase + q0 + qq;
#pragma unroll
    for (int i = 0; i < 4; ++i) { const int sl = lane + 64 * i; SEL[row * 256 + sl] = (unsigned)sl < n ? (unsigned short)(8191u - (lists[qq * LC + sl] & 0x1fffu)) : (unsigned short)0; }
    if (lane == 0) NSEL[row] = (int)n;
  }
  __syncthreads();
}

__device__ __forceinline__ void sparse_attn_phase(LAS unsigned char* lds, const bf16_t* H, const unsigned short* SEL, const int* NSEL, bf16_t* MIX) {
  const int tid = threadIdx.x, lane = tid & 63, wid = __builtin_amdgcn_readfirstlane(tid >> 6), r = lane & 31, h = lane >> 5;
  const int gw = blockIdx.x * NWAVES + wid, NGW = gridDim.x * NWAVES;
  LAS unsigned char* vbuf = lds + wid * 8192;
  const int i16 = lane & 15, q4 = i16 >> 2, p4 = i16 & 3, g16 = (lane >> 4) & 1;
  const unsigned troff = (4 * h + q4) * 128 + (16 * g16 + 4 * p4) * 2;
  for (int row = gw; row < M; row += NGW) {
    const size_t rowbase = (size_t)(row >> 13) * SEQ;
    const int n = __builtin_amdgcn_readfirstlane(NSEL[row]);
    const int nt = (n + 31) >> 5;
    bf16x8 Bq[4];
#pragma unroll
    for (int ks = 0; ks < 4; ++ks) { bf16x8 v = ldg16(H + (size_t)row * HP + C_BQ + (r & 7) * 64 + 16 * ks + 8 * h); if (r >= 8) v = (bf16x8){0, 0, 0, 0, 0, 0, 0, 0}; Bq[ks] = v; }
    f32x16 O[2];
#pragma unroll
    for (int dt = 0; dt < 2; ++dt)
#pragma unroll
      for (int i = 0; i < 16; ++i) O[dt][i] = 0.f;
    float mx = -INFINITY, sum = 0.f;
    for (int tl = 0; tl < nt; ++tl) {
      LAS unsigned char* vb = vbuf + (tl & 1) * 4096;
      const int sl = 32 * tl + r; const int kidx = sl < n ? (int)SEL[(size_t)row * 256 + sl] : 0;
      bf16x8 A[4];
#pragma unroll
      for (int ks = 0; ks < 4; ++ks) A[ks] = ldg16(H + (rowbase + kidx) * HP + C_BK + 16 * ks + 8 * h);
      u32x4 vv[4];
#pragma unroll
      for (int i = 0; i < 4; ++i) {
        const int kl = (lane >> 3) + 8 * i, sv = 32 * tl + kl; const int kiv = sv < n ? (int)SEL[(size_t)row * 256 + sv] : 0;
        vv[i] = *(const u32x4*)(H + (rowbase + kiv) * HP + C_BV + (lane & 7) * 8);
      }
      f32x16 S;
#pragma unroll
      for (int i = 0; i < 16; ++i) S[i] = 0.f;
#pragma unroll
      for (int ks = 0; ks < 4; ++ks) S = MFMA32(A[ks], Bq[ks], S);
      float tm = -INFINITY;
#pragma unroll
      for (int i = 0; i < 16; ++i) { const bool valid = 32 * tl + crow(i, h) < n; S[i] = valid ? S[i] : -INFINITY; tm = fmaxf(tm, S[i]); }
      tm = fmaxf(tm, __shfl_xor(tm, 32));
      const float mn = fmaxf(mx, tm), corr = exp2f(mx - mn);
      mx = mn;
      float ps = 0.f;
#pragma unroll
      for (int i = 0; i < 16; ++i) { const float p = exp2f(S[i] - mn); S[i] = p; ps += p; }
      sum = sum * corr + ps;
#pragma unroll
      for (int dt = 0; dt < 2; ++dt)
#pragma unroll
        for (int i = 0; i < 16; ++i) O[dt][i] *= corr;
#pragma unroll
      for (int i = 0; i < 4; ++i) *(LAS u32x4*)(vb + ((lane >> 3) + 8 * i) * 128 + (lane & 7) * 16) = vv[i];
      LDSWAIT();
#pragma unroll
      for (int s = 0; s < 2; ++s) {
        const bf16x8 P = pack8(S, s);
#pragma unroll
        for (int dt = 0; dt < 2; ++dt) {
          LAS unsigned char* p = vb + troff + (16 * s) * 128 + dt * 64;
          const s16x4 lo = tr_read(p), hi = tr_read(p + 8 * 128);
          const bf16x8 A2 = __builtin_shufflevector(lo, hi, 0, 1, 2, 3, 4, 5, 6, 7);
          O[dt] = MFMA32(A2, P, O[dt]);
        }
      }
    }
    sum += __shfl_xor(sum, 32);
    const float rs = 1.0f / sum;
    if (r < 8) {
#pragma unroll
      for (int dt = 0; dt < 2; ++dt)
#pragma unroll
        for (int g4 = 0; g4 < 4; ++g4) {
          const int d = 32 * dt + 8 * g4 + 4 * h;
          const u32x2 gt = *(const u32x2*)(H + (size_t)row * HP + C_BG + r * 64 + d);
          const float o0 = O[dt][4 * g4 + 0] * rs * __uint_as_float(gt.x << 16), o1 = O[dt][4 * g4 + 1] * rs * __uint_as_float(gt.x & 0xffff0000u);
          const float o2 = O[dt][4 * g4 + 2] * rs * __uint_as_float(gt.y << 16), o3 = O[dt][4 * g4 + 3] * rs * __uint_as_float(gt.y & 0xffff0000u);
          u32x2 w; w.x = cvt_pk_bf16(o0, o1); w.y = cvt_pk_bf16(o2, o3);
          *(u32x2*)(MIX + (size_t)row * DM + 512 + r * 64 + d) = w;
        }
    }
    LDSWAIT();
  }
}

__device__ __forceinline__ float wave_sum(float v) {
#pragma unroll
  for (int o = 1; o < 64; o <<= 1) v += __shfl_xor(v, o);
  return v;
}
__device__ __forceinline__ void ln_phase(const float* Y, const float* g, const float* bta, float* out) {
  const int tid = threadIdx.x, lane = tid & 63, wid = tid >> 6;
  const int gw = blockIdx.x * NWAVES + wid, NGW = gridDim.x * NWAVES;
  f32x4 gv[4], bv[4];
#pragma unroll
  for (int j = 0; j < 4; ++j) { gv[j] = *(const f32x4*)(g + 4 * lane + 256 * j); bv[j] = *(const f32x4*)(bta + 4 * lane + 256 * j); }
  for (int row = gw; row < M; row += NGW) {
    const f32x4* yr = (const f32x4*)(Y + (size_t)row * DM) + lane;
    f32x4 v[4]; float s = 0.f;
#pragma unroll
    for (int j = 0; j < 4; ++j) { v[j] = yr[64 * j]; s += (v[j][0] + v[j][1]) + (v[j][2] + v[j][3]); }
    const float mean = wave_sum(s) * (1.f / DM); float s2 = 0.f;
#pragma unroll
    for (int j = 0; j < 4; ++j) { v[j] = v[j] - mean; s2 += (v[j][0] * v[j][0] + v[j][1] * v[j][1]) + (v[j][2] * v[j][2] + v[j][3] * v[j][3]); }
    const float rstd = 1.f / sqrtf(wave_sum(s2) * (1.f / DM) + LN_EPS);
    f32x4* o = (f32x4*)(out + (size_t)row * DM) + lane;
#pragma unroll
    for (int j = 0; j < 4; ++j) o[64 * j] = v[j] * rstd * gv[j] + bv[j];
  }
}

#ifndef PHMASK
#define PHMASK 255
#endif
__global__ void __launch_bounds__(NTHREADS, 2) hybrid_fwd(Args a) {
  extern __shared__ __attribute__((aligned(16))) unsigned char lds_raw[];
  LAS unsigned char* lds = (LAS unsigned char*)lds_raw;
  cg::grid_group grid = cg::this_grid();
  const int tid = threadIdx.x;
  bf16_t* BTIN = (bf16_t*)(a.ws + WS_BTIN); bf16_t* BTOUT = (bf16_t*)(a.ws + WS_BTOUT);
  bf16_t* XN = (bf16_t*)(a.ws + WS_XN); bf16_t* H = (bf16_t*)(a.ws + WS_H); bf16_t* MIX = (bf16_t*)(a.ws + WS_MIX);
  float* IW = (float*)(a.ws + WS_IW); float* YPRE = (float*)(a.ws + WS_YPRE);
  int* NSEL = (int*)(a.ws + WS_NSEL); unsigned short* SEL = (unsigned short*)(a.ws + WS_SEL);
  unsigned* ctl = (unsigned*)(a.ws + WS_CTL);
  if (PHMASK & 1) p0_prologue(a, lds);
  grid.sync();
  if (PHMASK & 2) {
    pg8::Gemm g{XN, BTIN, M, NPAD, DM}; pg8::StaticOrder S; S.init(M, NPAD, (int)gridDim.x, (int)blockIdx.x);
    EpiInProj E{H, IW, a.b_in, (const f32x2*)(a.ws + WS_CS)};
    pg8::gemm_phase<EpiInProj, pg8::StaticOrder, true, true>(lds, g, S, E);
  }
  grid.sync();
  if (PHMASK & 4) {
    LAS int* us = (LAS int*)(lds + L_UNIT);
    if (PHMASK & 64) for (;;) {
      if (tid == 0) *us = (int)__hip_atomic_fetch_add(ctl, 1u, __ATOMIC_RELAXED, __HIP_MEMORY_SCOPE_AGENT);
      __syncthreads();
      const int u = *us;
      __syncthreads();
      if (u >= 512) break;
      indexer_unit(lds, u, H, IW, SEL, NSEL);
    }
    if (PHMASK & 128) for (;;) {
      if (tid == 0) *us = (int)__hip_atomic_fetch_add(ctl + 64, 1u, __ATOMIC_RELAXED, __HIP_MEMORY_SCOPE_AGENT);
      __syncthreads();
      const int u = *us;
      __syncthreads();
      if (u >= 512) break;
      swa_unit(lds, u, H, a.sinks, MIX);
    }
  }
  grid.sync();
  if (PHMASK & 8) sparse_attn_phase(lds, H, SEL, NSEL, MIX);
  grid.sync();
  if (PHMASK & 16) {
    pg8::Gemm g{MIX, BTOUT, M, DM, DM}; pg8::StaticOrder S; S.init(M, DM, (int)gridDim.x, (int)blockIdx.x);
    EpiOutProj E{YPRE, a.b_out, a.x};
    pg8::gemm_phase<EpiOutProj, pg8::StaticOrder, true, true>(lds, g, S, E);
  }
  grid.sync();
  if (PHMASK & 32) ln_phase(YPRE, a.ln_g, a.ln_b, a.out);
}

extern "C" void kernel_launch(void* const* d_in, const int* in_sizes, int n_in, void* d_out, int out_size, void* d_ws, size_t ws_size, hipStream_t stream) {
  static int grid = 0;
  if (grid == 0) {
    if (n_in != 9 || ws_size < WS_END) { fprintf(stderr, "kernel_launch: unexpected inputs (n_in %d, ws %zu)\n", n_in, ws_size); grid = -1; return; }
    int dev = 0, cus = 0, per_cu = 0;
    (void)hipGetDevice(&dev); (void)hipDeviceGetAttribute(&cus, hipDeviceAttributeMultiprocessorCount, dev);
    if (hipFuncSetAttribute((const void*)hybrid_fwd, hipFuncAttributeMaxDynamicSharedMemorySize, LDS_BYTES) != hipSuccess) { fprintf(stderr, "kernel_launch: hipFuncSetAttribute failed\n"); grid = -1; return; }
    (void)hipOccupancyMaxActiveBlocksPerMultiprocessor(&per_cu, (const void*)hybrid_fwd, NTHREADS, LDS_BYTES);
    if (per_cu < 1) { fprintf(stderr, "kernel_launch: occupancy query says %d blocks per CU\n", per_cu); per_cu = 1; }
    (void)hipGetLastError();
    grid = cus;
  }
  if (grid < 0) return;
  (void)hipMemsetAsync((char*)d_ws + WS_CTL, 0, 4096, stream);
  Args a{};
  a.x = (const float*)d_in[0]; a.pos = (const int*)d_in[1]; a.w_in = (const float*)d_in[2]; a.b_in = (const float*)d_in[3]; a.sinks = (const float*)d_in[4];
  a.w_out = (const float*)d_in[5]; a.b_out = (const float*)d_in[6]; a.ln_g = (const float*)d_in[7]; a.ln_b = (const float*)d_in[8];
  a.out = (float*)d_out; a.ws = (unsigned char*)d_ws;
  void* args[] = {&a};
  hipError_t e = hipLaunchCooperativeKernel((const void*)hybrid_fwd, dim3(grid), dim3(NTHREADS), args, LDS_BYTES, stream);
  if (e != hipSuccess) fprintf(stderr, "kernel_launch: cooperative launch failed: %s (grid %d)\n", hipGetErrorString(e), grid);
}
```

```cpp
#include <hip/hip_runtime.h>
#include <hip/hip_cooperative_groups.h>
#include <cstdio>
#include <cstdint>
namespace cg = cooperative_groups;
namespace pg8 {
#define PG8_LAS __attribute__((address_space(3)))
typedef unsigned short bf16_t;
typedef short bf16x8 __attribute__((ext_vector_type(8)));
typedef float f32x4 __attribute__((ext_vector_type(4)));
typedef unsigned u32x4 __attribute__((ext_vector_type(4)));
constexpr int BM = 256, BK = 64, HALF = 128, HTB = HALF * BK * 2  , STAGE_BYTES = 8 * HTB, NXCD = 8, WGM = 8;

__host__ __device__ __forceinline__ int lds_byte(int r, int c) { const int st = (r >> 4) * 2 + (c >> 5), rr = r & 15, cc = c & 31, ob = rr * 64 + cc * 2; return st * 1024 + (ob ^ (((ob >> 9) & 1) << 5)); }
__host__ __device__ __forceinline__ void stage_rc(int b, int& R, int& C) { const int st = b / 1024, sb = b % 1024, swz = sb ^ (((sb >> 9) & 1) << 5); R = (st >> 1) * 16 + swz / 64; C = (st & 1) * 32 + (swz % 64) / 2; }
__host__ __device__ __forceinline__ int perm32(int rho) { const int n = rho >> 4, i = rho & 15; return 8 * (i >> 2) + 4 * n + (i & 3); }

struct Unit { int pm, pn; };
struct Gemm { const bf16_t* A; const bf16_t* Bt; int M, N, K; };

struct StaticOrder {
    int nM, nN, nwg, G, c;
    __host__ __device__ void init(int M, int N, int G_, int c_) { nM = M / BM; nN = N / BM; nwg = nM * nN; G = G_; c = c_; }
    __host__ __device__ bool next(int i, Unit& u) const {
        const long L = (long)i * G + c; if (L >= nwg) return false;
        int wgid = (int)L; { const int q = nwg / NXCD, r = nwg % NXCD, xcd = wgid % NXCD, off = wgid / NXCD; wgid = (xcd < r ? xcd * (q + 1) : r * (q + 1) + (xcd - r) * q) + off; }
        const int nig = WGM * nN, gid = wgid / nig, fm = gid * WGM, gsz = (nM - fm) < WGM ? (nM - fm) : WGM;
        u.pm = fm + ((wgid % nig) % gsz); u.pn = (wgid % nig) / gsz; return true;
    }
    __device__ __forceinline__ void a_ready(const Unit&) const {}
    __device__ __forceinline__ void done(const Unit&) const {}
};

__device__ __forceinline__ unsigned cvt_pk_bf16(float lo, float hi) { unsigned r; asm volatile("v_cvt_pk_bf16_f32 %0, %1, %2" : "=v"(r) : "v"(lo), "v"(hi)); return r; }
template <class Epi, class Sched, bool ALIGN_EPI = false, bool SP2 = false>
__device__ __forceinline__ void gemm_phase(PG8_LAS unsigned char* lds, const Gemm g, const Sched& S, const Epi& E) {
    const int tid = threadIdx.x, wid = __builtin_amdgcn_readfirstlane(tid >> 6), lane = tid & 63, wr = wid >> 2, wc = wid & 3, fr = lane & 15, fq = lane >> 4;
    const int K = g.K, nt = K / BK;
    unsigned voffA[2], voffB[2];
#pragma unroll
    for (int i = 0; i < 2; ++i) { int R, C; stage_rc(tid * 16 + i * 8192, R, C); const int Rb = Epi::PERM ? ((R & ~31) + perm32(R & 31)) : R;
        voffA[i] = (unsigned)(R * K + C) * 2u; voffB[i] = (unsigned)(Rb * K + C) * 2u; }
    const size_t kstep = (size_t)(BK * 2);
    const size_t hstep = (size_t)HALF * K * 2;
    const size_t tstep = 2 * hstep;
    const unsigned ldsw = (unsigned)wid * 1024u;
    const int aoff = lds_byte(wr * 64 + fr, fq * 8), boff = lds_byte(wc * 32 + fr, fq * 8);
#define PG8_SA(b, h) (((b) * 2 + (h)) * HTB)
#define PG8_SB(b, h) ((4 + (b) * 2 + (h)) * HTB)
#define PG8_STAGE(bufoff, gbase, voff) do { _Pragma("unroll") for (int _i = 0; _i < 2; ++_i) \
        __builtin_amdgcn_global_load_lds((const unsigned*)((const char*)(gbase) + (voff)[_i]), (PG8_LAS unsigned*)(lds + (bufoff) + ldsw + _i * 8192), 16, 0, 0); } while (0)
#define PG8_LDA(dst, b, h) do { _Pragma("unroll") for (int m = 0; m < 4; ++m) _Pragma("unroll") for (int k = 0; k < 2; ++k) dst[m][k] = *(const PG8_LAS bf16x8*)(lds + PG8_SA(b, h) + aoff + m * 2048 + k * 1024); } while (0)
#define PG8_LDB(dst, b, h) do { _Pragma("unroll") for (int n = 0; n < 2; ++n) _Pragma("unroll") for (int k = 0; k < 2; ++k) dst[n][k] = *(const PG8_LAS bf16x8*)(lds + PG8_SB(b, h) + boff + n * 2048 + k * 1024); } while (0)
#define PG8_MMA(ai, bj, At, Bt) do { __builtin_amdgcn_s_setprio(1); _Pragma("unroll") for (int m = 0; m < 4; ++m) _Pragma("unroll") for (int n = 0; n < 2; ++n) _Pragma("unroll") for (int k = 0; k < 2; ++k) \
        acc[ai][bj][m][n] = __builtin_amdgcn_mfma_f32_16x16x32_bf16(Bt[n][k], At[m][k], acc[ai][bj][m][n], 0, 0, 0); __builtin_amdgcn_s_setprio(0); } while (0)
#define PG8_WAIT_V(n) asm volatile("s_waitcnt vmcnt(" #n ")" ::: "memory")
#define PG8_WAIT_L(n) asm volatile("s_waitcnt lgkmcnt(" #n ")" ::: "memory")
#define PG8_BAR __builtin_amdgcn_s_barrier()
#define PG8_SCHED __builtin_amdgcn_sched_barrier(0)
    Unit cur, nxt; int ui = 0;
    if (!S.next(0, cur)) return;
    f32x4 acc[2][2][4][2];
#pragma unroll
    for (int a = 0; a < 2; ++a)
#pragma unroll
        for (int b = 0; b < 2; ++b)
#pragma unroll
            for (int m = 0; m < 4; ++m)
#pragma unroll
                for (int n = 0; n < 2; ++n) acc[a][b][m][n] = (f32x4){0.f, 0.f, 0.f, 0.f};
    bf16x8 At[4][2], B0[2][2], B1[2][2];
    const char* cA = (const char*)g.A + (size_t)cur.pm * tstep; const char* cB = (const char*)g.Bt + (size_t)cur.pn * tstep;
    S.a_ready(cur);
    if constexpr (SP2) {
        PG8_STAGE(PG8_SB(0, 0), cB, voffB); PG8_STAGE(PG8_SB(0, 1), cB + hstep, voffB); PG8_STAGE(PG8_SA(0, 0), cA, voffA); PG8_STAGE(PG8_SA(0, 1), cA + hstep, voffA);
        if (wr == 1) PG8_BAR;
        PG8_WAIT_V(2); PG8_BAR;
        PG8_STAGE(PG8_SB(1, 0), cB + kstep, voffB); PG8_STAGE(PG8_SA(1, 0), cA + kstep, voffA); PG8_STAGE(PG8_SB(1, 1), cB + hstep + kstep, voffB);
        PG8_WAIT_V(6); PG8_BAR;
    } else {
        PG8_STAGE(PG8_SB(0, 0), cB, voffB); PG8_STAGE(PG8_SA(0, 0), cA, voffA); PG8_STAGE(PG8_SB(0, 1), cB + hstep, voffB); PG8_STAGE(PG8_SA(0, 1), cA + hstep, voffA);
        if (wr == 1) PG8_BAR;
        PG8_WAIT_V(4); PG8_BAR;
        PG8_STAGE(PG8_SB(1, 0), cB + kstep, voffB); PG8_STAGE(PG8_SA(1, 0), cA + kstep, voffA); PG8_STAGE(PG8_SB(1, 1), cB + hstep + kstep, voffB);
        PG8_WAIT_V(6); PG8_BAR;
    }
    for (;;) {
        const bool has_next = S.next(ui + 1, nxt);
        const char* nA = has_next ? (const char*)g.A + (size_t)nxt.pm * tstep : cA; const char* nB = has_next ? (const char*)g.Bt + (size_t)nxt.pn * tstep : cB;
        for (int t = 0; t < nt; t += 2) {
            const bool last = (t == nt - 2);
            const char* a1 = cA + (size_t)(t + 1) * kstep;
            const char* a2 = last ? nA : cA + (size_t)(t + 2) * kstep; const char* b2 = last ? nB : cB + (size_t)(t + 2) * kstep;
            const char* a3 = a2 + kstep; const char* b3 = b2 + kstep;
            if (last && has_next) S.a_ready(nxt);
            if constexpr (SP2) {
            PG8_LDB(B0, 0, 0); PG8_LDB(B1, 0, 1); PG8_SCHED; PG8_LDA(At, 0, 0); PG8_STAGE(PG8_SA(1, 1), a1 + hstep, voffA);
            PG8_WAIT_V(8); PG8_WAIT_L(0); PG8_BAR; PG8_MMA(0, 0, At, B0); PG8_MMA(0, 1, At, B1); PG8_BAR; PG8_SCHED;
            PG8_LDA(At, 0, 1); PG8_STAGE(PG8_SB(0, 0), b2, voffB); PG8_STAGE(PG8_SB(0, 1), b2 + hstep, voffB); PG8_STAGE(PG8_SA(0, 0), a2, voffA);
            PG8_WAIT_V(8); PG8_WAIT_L(0); PG8_BAR; PG8_MMA(1, 0, At, B0); PG8_MMA(1, 1, At, B1); PG8_BAR; PG8_SCHED;
            PG8_LDB(B0, 1, 0); PG8_LDB(B1, 1, 1); PG8_SCHED; PG8_LDA(At, 1, 0); PG8_STAGE(PG8_SA(0, 1), a2 + hstep, voffA);
            PG8_WAIT_V(8); PG8_WAIT_L(0); PG8_BAR; PG8_MMA(0, 0, At, B0); PG8_MMA(0, 1, At, B1); PG8_BAR; PG8_SCHED;
            PG8_LDA(At, 1, 1); PG8_STAGE(PG8_SB(1, 0), b3, voffB); PG8_STAGE(PG8_SB(1, 1), b3 + hstep, voffB); PG8_STAGE(PG8_SA(1, 0), a3, voffA);
            PG8_WAIT_V(8); PG8_WAIT_L(0); PG8_BAR; PG8_MMA(1, 0, At, B0); PG8_MMA(1, 1, At, B1); PG8_BAR; PG8_SCHED;
            } else {
            PG8_LDB(B0, 0, 0); PG8_SCHED; PG8_LDA(At, 0, 0); PG8_STAGE(PG8_SA(1, 1), a1 + hstep, voffA);
            PG8_WAIT_L(8); PG8_BAR; PG8_WAIT_L(0); PG8_MMA(0, 0, At, B0); PG8_BAR; PG8_SCHED;
            PG8_LDB(B1, 0, 1); PG8_STAGE(PG8_SB(0, 0), b2, voffB);
            PG8_BAR; PG8_WAIT_L(0); PG8_MMA(0, 1, At, B1); PG8_BAR;
            PG8_LDA(At, 0, 1); PG8_STAGE(PG8_SA(0, 0), a2, voffA);
            PG8_BAR; PG8_WAIT_L(0); PG8_MMA(1, 0, At, B0); PG8_BAR; PG8_SCHED;
            PG8_STAGE(PG8_SB(0, 1), b2 + hstep, voffB);
            PG8_WAIT_V(6); PG8_BAR; PG8_MMA(1, 1, At, B1); PG8_BAR;
            PG8_LDB(B0, 1, 0); PG8_SCHED; PG8_LDA(At, 1, 0); PG8_STAGE(PG8_SA(0, 1), a2 + hstep, voffA);
            PG8_WAIT_L(8); PG8_BAR; PG8_WAIT_L(0); PG8_MMA(0, 0, At, B0); PG8_BAR; PG8_SCHED;
            PG8_LDB(B1, 1, 1); PG8_STAGE(PG8_SB(1, 0), b3, voffB);
            PG8_BAR; PG8_WAIT_L(0); PG8_MMA(0, 1, At, B1); PG8_BAR;
            PG8_LDA(At, 1, 1); PG8_STAGE(PG8_SA(1, 0), a3, voffA);
            PG8_BAR; PG8_WAIT_L(0); PG8_MMA(1, 0, At, B0); PG8_BAR; PG8_SCHED;
            PG8_STAGE(PG8_SB(1, 1), b3 + hstep, voffB);
            PG8_WAIT_V(6); PG8_BAR; PG8_MMA(1, 1, At, B1); PG8_BAR;
            }
        }
        if constexpr (ALIGN_EPI) { if (wr == 0) PG8_BAR; }
        if constexpr (!Epi::AFTER_DRAIN) { E(acc, cur, wr, wc, fr, fq); S.done(cur); }
        if (!has_next) break;
#pragma unroll
        for (int a = 0; a < 2; ++a)
#pragma unroll
            for (int b = 0; b < 2; ++b)
#pragma unroll
                for (int m = 0; m < 4; ++m)
#pragma unroll
                    for (int n = 0; n < 2; ++n) acc[a][b][m][n] = (f32x4){0.f, 0.f, 0.f, 0.f};
        cur = nxt; cA = nA; cB = nB; ++ui;
        if constexpr (ALIGN_EPI) { if (wr == 1) PG8_BAR; }
    }
    PG8_WAIT_V(0);
    if constexpr (!ALIGN_EPI) { if (wr == 0) PG8_BAR; }
    PG8_BAR;
    if constexpr (Epi::AFTER_DRAIN) { E.fused(acc, cur, wr, wc, fr, fq, lds, wid, lane); S.done(cur); }
#undef PG8_SA
#undef PG8_SB
#undef PG8_STAGE
#undef PG8_LDA
#undef PG8_LDB
#undef PG8_MMA
#undef PG8_WAIT_V
#undef PG8_WAIT_L
#undef PG8_BAR
#undef PG8_SCHED
}
}
#define LAS __attribute__((address_space(3)))
typedef unsigned short bf16_t;
typedef short bf16x8 __attribute__((ext_vector_type(8)));
typedef short s16x4 __attribute__((ext_vector_type(4)));
typedef float f32x4 __attribute__((ext_vector_type(4)));
typedef float f32x2 __attribute__((ext_vector_type(2)));
typedef float f32x16 __attribute__((ext_vector_type(16)));
typedef unsigned u32x4 __attribute__((ext_vector_type(4)));
typedef unsigned u32x2 __attribute__((ext_vector_type(2)));
using pg8::cvt_pk_bf16;

constexpr int SEQ = 8192, NB = 2, M = NB * SEQ, DM = 1024, NCOL = 2756, NPAD = 2816, HP = 2752;
constexpr int C_AQ = 0, C_AK = 512, C_AV = 640, C_AG = 768, C_BQ = 1280, C_BK = 1792, C_BV = 1856, C_BG = 1920, C_IQ = 2432, C_IK = 2688, C_IW = 2752;
constexpr float LOG2E = 1.4426950408889634f, QSCALE = 0.125f * LOG2E, LN_EPS = 1e-5f;
constexpr float ALPHA = 1.189207115002721f;
constexpr size_t MiB = 1u << 20;
constexpr size_t WS_CTL = 0, WS_BTIN = 2 * MiB, WS_BTOUT = 8 * MiB, WS_CS = 10 * MiB, WS_IW = 14 * MiB, WS_NSEL = 15 * MiB, WS_SEL = 16 * MiB,
                 WS_XN = 24 * MiB, WS_H = 56 * MiB, WS_MIX = 142 * MiB, WS_YPRE = 174 * MiB, WS_END = 238 * MiB;
constexpr int LDS_BYTES = 147456;
constexpr int NTHREADS = 512, NWAVES = 8;
#define MFMA32(a, b, c) __builtin_amdgcn_mfma_f32_32x32x16_bf16((a), (b), (c), 0, 0, 0)
#define LDSWAIT() asm volatile("s_waitcnt lgkmcnt(0)" ::: "memory")

__device__ __forceinline__ int crow(int i, int h) { return (i & 3) + 8 * (i >> 2) + 4 * h; }
__device__ __forceinline__ int swap45(int c) { return (c & ~48) | ((c & 16) << 1) | ((c & 32) >> 1); }
__device__ __forceinline__ float bf2f(unsigned short b) { return __uint_as_float((unsigned)b << 16); }
__device__ __forceinline__ bf16x8 ldg16(const bf16_t* p) { return *(const bf16x8*)p; }
__device__ __forceinline__ bf16x8 pack8(const f32x16& x, int s) {
  u32x4 p; p.x = cvt_pk_bf16(x[8 * s + 0], x[8 * s + 1]); p.y = cvt_pk_bf16(x[8 * s + 2], x[8 * s + 3]); p.z = cvt_pk_bf16(x[8 * s + 4], x[8 * s + 5]); p.w = cvt_pk_bf16(x[8 * s + 6], x[8 * s + 7]);
  return __builtin_bit_cast(bf16x8, p);
}
__device__ __forceinline__ s16x4 tr_read(LAS unsigned char* p) { return __builtin_amdgcn_ds_read_tr16_b64_v4i16((LAS s16x4*)p); }

struct Args { const float* x; const int* pos; const float* w_in; const float* b_in; const float* sinks; const float* w_out; const float* b_out; const float* ln_g; const float* ln_b;
              float* out; unsigned char* ws; };

__device__ __forceinline__ void p0_transpose_item(const float* W, int N, bf16_t* WT, bool perm, LAS float* scr, int item, int nblk, int lane) {
  const int kb = item / nblk, nb = item % nblk, k0 = 64 * kb, n0 = 32 * nb;
  const int nn = n0 + (lane & 31);
#pragma unroll 8
  for (int i = 0; i < 32; ++i) { const int kk = 2 * i + (lane >> 5); scr[kk * 33 + (lane & 31)] = nn < N ? W[(size_t)(k0 + kk) * N + nn] : 0.f; }
  LDSWAIT();
  const int c = lane & 7;
#pragma unroll
  for (int j = 0; j < 4; ++j) { const int n = (lane >> 3) + 8 * j; const LAS float* s = scr + (8 * c) * 33 + n;
    u32x4 o; o.x = cvt_pk_bf16(s[0 * 33], s[1 * 33]); o.y = cvt_pk_bf16(s[2 * 33], s[3 * 33]); o.z = cvt_pk_bf16(s[4 * 33], s[5 * 33]); o.w = cvt_pk_bf16(s[6 * 33], s[7 * 33]);
    const int grow = perm ? swap45(n0 + n) : (n0 + n);
    *(u32x4*)(WT + (size_t)grow * 1024 + k0 + 8 * c) = o; }
  LDSWAIT();
}
__device__ __forceinline__ void p0_prologue(const Args& a, LAS unsigned char* lds) {
  const int tid = threadIdx.x, lane = tid & 63, wid = tid >> 6;
  const int gw = blockIdx.x * NWAVES + wid, NGW = gridDim.x * NWAVES;
  LAS float* scr = (LAS float*)(lds + wid * 16384);
  bf16_t* BTIN = (bf16_t*)(a.ws + WS_BTIN); bf16_t* BTOUT = (bf16_t*)(a.ws + WS_BTOUT);
  constexpr int NBI = NPAD / 32, I_IN = 16 * NBI, I_OUT = 16 * 32;
  for (int it = gw; it < I_IN + I_OUT; it += NGW) {
    if (it < I_IN) p0_transpose_item(a.w_in, NCOL, BTIN, true, scr, it, NBI, lane);
    else p0_transpose_item(a.w_out, DM, BTOUT, false, scr, it - I_IN, 32, lane);
  }
  const int gt = blockIdx.x * NTHREADS + tid, NGT = gridDim.x * NTHREADS;
  bf16_t* XN = (bf16_t*)(a.ws + WS_XN);
  for (int i = gt; i < M * DM / 8; i += NGT) {
    const f32x4 v0 = *(const f32x4*)(a.x + (size_t)i * 8), v1 = *(const f32x4*)(a.x + (size_t)i * 8 + 4);
    u32x4 o; o.x = cvt_pk_bf16(v0[0], v0[1]); o.y = cvt_pk_bf16(v0[2], v0[3]); o.z = cvt_pk_bf16(v1[0], v1[1]); o.w = cvt_pk_bf16(v1[2], v1[3]);
    *(u32x4*)(XN + (size_t)i * 8) = o;
  }
  f32x2* CS = (f32x2*)(a.ws + WS_CS);
  for (int i = gt; i < M * 32; i += NGT) {
    const int row = i >> 5, j = i & 31;
    const float inv = exp2f(-(float)j * (13.287712379549449f / 32.0f));
    const float ang = (float)a.pos[row] * inv;
    CS[i] = (f32x2){cosf(ang), sinf(ang)};
  }
}

struct EpiInProj {
  static constexpr bool PERM = false, AFTER_DRAIN = false;
  bf16_t* H; float* IW; const float* bias; const f32x2* CS;
  __device__ __forceinline__ void operator()(const f32x4 (&acc)[2][2][4][2], const pg8::Unit& u, int wr, int wc, int fr, int fq) const {
    const int row0 = u.pm * 256 + wr * 64 + fr;
    const int dloc = 16 * (wc & 1) + 4 * fq;
#pragma unroll
    for (int bj = 0; bj < 2; ++bj) {
      const int G = 4 * u.pn + 2 * bj + (wc >> 1);
      if (G >= 44) continue;
      const int col1 = 64 * G + dloc;
      if (G == 43) {
        if (dloc == 0) {
          const f32x4 b1 = *(const f32x4*)(bias + col1);
#pragma unroll
          for (int ai = 0; ai < 2; ++ai)
#pragma unroll
            for (int m = 0; m < 4; ++m) { const int row = row0 + 128 * ai + 16 * m; *(f32x4*)(IW + (size_t)row * 4) = (acc[ai][bj][m][0] + b1) * 0.0625f; }
        }
        continue;
      }
      const f32x4 b1 = *(const f32x4*)(bias + col1), b2 = *(const f32x4*)(bias + col1 + 32);
      const bool rope = (G < 10) || (G >= 20 && G < 29) || (G >= 38);
      const bool silu = (G >= 12 && G < 20) || (G >= 30 && G < 38);
      const float sc = ((G < 8) || (G >= 20 && G < 28)) ? QSCALE : 1.0f;
#pragma unroll
      for (int ai = 0; ai < 2; ++ai)
#pragma unroll
        for (int m = 0; m < 4; ++m) {
          const int row = row0 + 128 * ai + 16 * m;
          f32x4 v1 = acc[ai][bj][m][0] + b1, v2 = acc[ai][bj][m][1] + b2;
          if (rope) {
            const f32x4 cs0 = *(const f32x4*)((const float*)CS + ((size_t)row * 32 + dloc) * 2), cs1 = *(const f32x4*)((const float*)CS + ((size_t)row * 32 + dloc) * 2 + 4);
            const f32x4 c = {cs0[0], cs0[2], cs1[0], cs1[2]}, s = {cs0[1], cs0[3], cs1[1], cs1[3]};
            const f32x4 o1 = v1 * c - v2 * s, o2 = v2 * c + v1 * s;
            v1 = o1 * sc; v2 = o2 * sc;
          } else if (silu) {
#pragma unroll
            for (int i = 0; i < 4; ++i) { v1[i] = v1[i] / (1.0f + __expf(-v1[i])); v2[i] = v2[i] / (1.0f + __expf(-v2[i])); }
          }
          u32x2 w1, w2; w1.x = cvt_pk_bf16(v1[0], v1[1]); w1.y = cvt_pk_bf16(v1[2], v1[3]); w2.x = cvt_pk_bf16(v2[0], v2[1]); w2.y = cvt_pk_bf16(v2[2], v2[3]);
          bf16_t* p = H + (size_t)row * HP + col1;
          *(u32x2*)p = w1; *(u32x2*)(p + 32) = w2;
        }
    }
  }
};
struct EpiOutProj {
  static constexpr bool PERM = false, AFTER_DRAIN = false;
  float* Y; const float* bias; const float* x;
  __device__ __forceinline__ void operator()(const f32x4 (&acc)[2][2][4][2], const pg8::Unit& u, int wr, int wc, int fr, int fq) const {
    const int row0 = u.pm * 256 + wr * 64 + fr, col0 = u.pn * 256 + wc * 32 + 4 * fq;
#pragma unroll
    for (int bj = 0; bj < 2; ++bj)
#pragma unroll
      for (int n = 0; n < 2; ++n) { const int col = col0 + 128 * bj + 16 * n; const f32x4 bv = *(const f32x4*)(bias + col);
#pragma unroll
        for (int ai = 0; ai < 2; ++ai)
#pragma unroll
          for (int m = 0; m < 4; ++m) { const size_t off = (size_t)(row0 + 128 * ai + 16 * m) * DM + col;
            *(f32x4*)(Y + off) = acc[ai][bj][m][n] + bv + ALPHA * *(const f32x4*)(x + off); } }
  }
};
__device__ __forceinline__ void swa_unit(LAS unsigned char* lds, int u, const bf16_t* H, const float* sinks, bf16_t* MIX) {
  const int tid = threadIdx.x, lane = tid & 63, wid = __builtin_amdgcn_readfirstlane(tid >> 6), r = lane & 31, h = lane >> 5;
  const int g = u & 1, qb = (u >> 1) & 127, b = u >> 8;
  const size_t rowbase = (size_t)b * SEQ;
  const int t00 = qb * 64, kbase = t00 - 128;
  for (int i = tid; i < 192 * 8; i += NTHREADS) {
    const int kl = i >> 3, piece = i & 7, key = kbase + kl;
    u32x4 v = {0u, 0u, 0u, 0u};
    if (key >= 0) v = *(const u32x4*)(H + (rowbase + key) * HP + C_AV + g * 64 + piece * 8);
    *(LAS u32x4*)(lds + kl * 128 + piece * 16) = v;
  }
  __syncthreads();
  const int r4 = wid & 3, sub = wid >> 2, hq = g * 4 + r4, t0 = t00 + 32 * sub;
  bf16x8 Bq[4];
#pragma unroll
  for (int ks = 0; ks < 4; ++ks) Bq[ks] = ldg16(H + (rowbase + t0 + r) * HP + C_AQ + hq * 64 + 16 * ks + 8 * h);
  f32x16 S[5];
#pragma unroll
  for (int tl = 0; tl < 5; ++tl) {
    const int key = t0 - 128 + 32 * tl + r, kc = key < 0 ? 0 : key;
    f32x16 acc;
#pragma unroll
    for (int i = 0; i < 16; ++i) acc[i] = 0.f;
#pragma unroll
    for (int ks = 0; ks < 4; ++ks) { const bf16x8 A = ldg16(H + (rowbase + kc) * HP + C_AK + g * 64 + 16 * ks + 8 * h); acc = MFMA32(A, Bq[ks], acc); }
    S[tl] = acc;
  }
  const float sk = sinks[hq] * LOG2E;
  float mx = sk;
#pragma unroll
  for (int tl = 0; tl < 5; ++tl)
#pragma unroll
    for (int i = 0; i < 16; ++i) {
      const int rel = r + 128 - 32 * tl - crow(i, h), key = t0 + r - rel;
      const bool valid = rel >= 0 && rel < 128 && key >= 0;
      S[tl][i] = valid ? S[tl][i] : -INFINITY;
      mx = fmaxf(mx, S[tl][i]);
    }
  mx = fmaxf(mx, __shfl_xor(mx, 32));
  float sum = 0.f;
#pragma unroll
  for (int tl = 0; tl < 5; ++tl)
#pragma unroll
    for (int i = 0; i < 16; ++i) { const float p = exp2f(S[tl][i] - mx); S[tl][i] = p; sum += p; }
  sum += __shfl_xor(sum, 32);
  sum += exp2f(sk - mx);
  const float rs = 1.0f / sum;
  f32x16 O[2];
#pragma unroll
  for (int dt = 0; dt < 2; ++dt)
#pragma unroll
    for (int i = 0; i < 16; ++i) O[dt][i] = 0.f;
  const int i16 = lane & 15, q4 = i16 >> 2, p4 = i16 & 3, g16 = (lane >> 4) & 1;
  LAS unsigned char* vb = lds + (32 * sub + 4 * h + q4) * 128 + (16 * g16 + 4 * p4) * 2;
#pragma unroll
  for (int tl = 0; tl < 5; ++tl)
#pragma unroll
    for (int s = 0; s < 2; ++s) {
      const bf16x8 P = pack8(S[tl], s);
#pragma unroll
      for (int dt = 0; dt < 2; ++dt) {
        LAS unsigned char* p = vb + (32 * tl + 16 * s) * 128 + dt * 64;
        const s16x4 lo = tr_read(p), hi = tr_read(p + 8 * 128);
        const bf16x8 A2 = __builtin_shufflevector(lo, hi, 0, 1, 2, 3, 4, 5, 6, 7);
        O[dt] = MFMA32(A2, P, O[dt]);
      }
    }
  const size_t row = rowbase + t0 + r;
#pragma unroll
  for (int dt = 0; dt < 2; ++dt)
#pragma unroll
    for (int g4 = 0; g4 < 4; ++g4) {
      const int d = 32 * dt + 8 * g4 + 4 * h;
      const u32x2 gt = *(const u32x2*)(H + row * HP + C_AG + hq * 64 + d);
      const float o0 = O[dt][4 * g4 + 0] * rs * __uint_as_float(gt.x << 16), o1 = O[dt][4 * g4 + 1] * rs * __uint_as_float(gt.x & 0xffff0000u);
      const float o2 = O[dt][4 * g4 + 2] * rs * __uint_as_float(gt.y << 16), o3 = O[dt][4 * g4 + 3] * rs * __uint_as_float(gt.y & 0xffff0000u);
      u32x2 w; w.x = cvt_pk_bf16(o0, o1); w.y = cvt_pk_bf16(o2, o3);
      *(u32x2*)(MIX + row * DM + hq * 64 + d) = w;
    }
  __syncthreads();
}

constexpr int LC = 768, L_SCR = 98304, L_HIST = 135168, L_CNT = 143360, L_TAU = 143488, L_WL = 143616, L_UNIT = 144128, L_BAR = 144256;
__device__ __forceinline__ void select_compact(LAS unsigned* L, unsigned n, LAS unsigned* hist, unsigned limit, LAS unsigned* cntp, LAS unsigned* taup, int lane) {
  unsigned prefix = 0u, mask = 0u, kk = 256u;
  for (int p = 0; p < 4; ++p) {
    const int shift = 24 - 8 * p;
    *(LAS u32x4*)(hist + 4 * lane) = (u32x4){0u, 0u, 0u, 0u};
    LDSWAIT();
    for (unsigned i = lane; i < n; i += 64) { const unsigned e = L[i]; if ((e & mask) == prefix) __hip_atomic_fetch_add(hist + ((e >> shift) & 255u), 1u, __ATOMIC_RELAXED, __HIP_MEMORY_SCOPE_WORKGROUP); }
    LDSWAIT();
    const u32x4 hb = *(LAS u32x4*)(hist + 4 * lane);
    const unsigned s4 = hb.x + hb.y + hb.z + hb.w;
    unsigned incl = s4;
#pragma unroll
    for (int o = 1; o < 64; o <<= 1) { const unsigned t = __shfl_down(incl, o); if (lane + o < 64) incl += t; }
    unsigned run = incl - s4;
    bool found = false; unsigned Bl = 0u, abl = 0u, bcl = 0u;
#pragma unroll
    for (int bb = 3; bb >= 0; --bb) { const unsigned c = hb[bb]; if (!found && run < kk && run + c >= kk) { found = true; Bl = 4u * lane + bb; abl = run; bcl = c; } run += c; }
    const unsigned long long fm = __ballot(found);
    const int src = __ffsll((long long)fm) - 1;
    const unsigned B = __shfl(Bl, src), above = __shfl(abl, src), bc = __shfl(bcl, src);
    prefix |= B << shift; mask |= 255u << shift;
    const unsigned kept = (256u - kk) + above + bc;
    kk -= above;
    if (kept <= limit) break;
  }
  unsigned off = 0u;
  for (unsigned base = 0; base < n; base += 64) {
    const unsigned i = base + lane; const unsigned e = (i < n) ? L[i] : 0u; const bool keep = (i < n) && (e >= prefix);
    const unsigned long long km = __ballot(keep);
    const unsigned pos = off + (unsigned)__popcll(km & ((1ull << lane) - 1ull));
    if (keep) L[pos] = e;
    off += (unsigned)__popcll(km);
  }
  if (lane == 0) { *cntp = off; *taup = prefix ? prefix - 1u : 0u; }
  LDSWAIT();
}

__device__ __forceinline__ void indexer_unit(LAS unsigned char* lds, int u, const bf16_t* H, const float* IW, unsigned short* SEL, int* NSEL) {
  const int tid = threadIdx.x, lane = tid & 63, wid = __builtin_amdgcn_readfirstlane(tid >> 6), r = lane & 31, h = lane >> 5;
  const int b = u & 1, qblk = 255 - (u >> 1);
  LAS unsigned* lists = (LAS unsigned*)lds;
  LAS unsigned* scr = (LAS unsigned*)(lds + L_SCR + wid * 4608);
  LAS unsigned* hist = (LAS unsigned*)(lds + L_HIST + wid * 1024);
  LAS unsigned* cnt = (LAS unsigned*)(lds + L_CNT);
  LAS unsigned* tau = (LAS unsigned*)(lds + L_TAU);
  LAS float* wl = (LAS float*)(lds + L_WL);
  const int q0 = qblk * 32; const size_t rowbase = (size_t)b * SEQ;
  if (tid < 32) { cnt[tid] = 0u; tau[tid] = 0u; *(LAS f32x4*)(wl + tid * 4) = *(const f32x4*)(IW + (rowbase + q0 + tid) * 4); }
  bf16x8 Aq[4][4];
#pragma unroll
  for (int rt = 0; rt < 4; ++rt)
#pragma unroll
    for (int ks = 0; ks < 4; ++ks) Aq[rt][ks] = ldg16(H + (rowbase + q0 + 8 * rt + (r >> 2)) * HP + C_IQ + (r & 3) * 64 + 16 * ks + 8 * h);
  __syncthreads();
  const int nch = (q0 + 32 + 255) >> 8;
  unsigned mytau = 0u; const int myq = lane & 31, mykh = lane >> 5;
  for (int c = 0; c < nch; ++c) {
    const int kt0 = c * 256 + wid * 32;
    if (kt0 <= q0 + 31) {
      bf16x8 Bk[4];
#pragma unroll
      for (int ks = 0; ks < 4; ++ks) Bk[ks] = ldg16(H + (rowbase + kt0 + r) * HP + C_IK + 16 * ks + 8 * h);
      const int key = kt0 + r;
#pragma unroll
      for (int rt = 0; rt < 4; ++rt) {
        f32x16 acc;
#pragma unroll
        for (int i = 0; i < 16; ++i) acc[i] = 0.f;
#pragma unroll
        for (int ks = 0; ks < 4; ++ks) acc = MFMA32(Aq[rt][ks], Bk[ks], acc);
#pragma unroll
        for (int g = 0; g < 4; ++g) {
          const int ql = 8 * rt + 2 * g + h;
          const f32x4 w = *(LAS f32x4*)(wl + ql * 4);
          const float s = w[0] * fmaxf(acc[4 * g], 0.f) + w[1] * fmaxf(acc[4 * g + 1], 0.f) + w[2] * fmaxf(acc[4 * g + 2], 0.f) + w[3] * fmaxf(acc[4 * g + 3], 0.f);
          unsigned ub = __float_as_uint(s); ub = (ub & 0x7fffffffu) ? ub : 0u;
          const unsigned ord = ub ^ ((unsigned)((int)ub >> 31) | 0x80000000u);
          unsigned enc = (ord & 0xffffe000u) | (unsigned)(8191 - key);
          if (key > q0 + ql) enc = 0u;
          scr[ql * 36 + r] = enc;
        }
      }
      LDSWAIT();
      u32x4 e[4];
#pragma unroll
      for (int i = 0; i < 4; ++i) e[i] = *(LAS u32x4*)(scr + myq * 36 + mykh * 16 + 4 * i);
      unsigned np = 0u;
#pragma unroll
      for (int i = 0; i < 4; ++i)
#pragma unroll
        for (int j = 0; j < 4; ++j) np += (e[i][j] > mytau) ? 1u : 0u;
      unsigned pos = 0u;
      if (np) pos = __hip_atomic_fetch_add(cnt + myq, np, __ATOMIC_RELAXED, __HIP_MEMORY_SCOPE_WORKGROUP);
      LAS unsigned* lp = lists + myq * LC;
#pragma unroll
      for (int i = 0; i < 4; ++i)
#pragma unroll
        for (int j = 0; j < 4; ++j) { const unsigned ev = e[i][j]; if (ev > mytau) { lp[pos] = ev; ++pos; } }
    }
    __syncthreads();
    const bool last = (c == nch - 1);
    for (int qq = wid; qq < 32; qq += 8) {
      const unsigned n = cnt[qq];
      if (last ? (n > 256u) : (n > (unsigned)(LC - 256))) select_compact(lists + qq * LC, n, hist, last ? 256u : 384u, cnt + qq, tau + qq, lane);
    }
    __syncthreads();
    mytau = tau[myq];
  }
  for (int qq = wid; qq < 32; qq += 8) {
    const unsigned n = cnt[qq]; const size_t row = rowbase + q0 + qq;
#pragma unroll
    for (int i = 0; i < 4; ++i) { const int sl = lane + 64 * i; SEL[row * 256 + sl] = (unsigned)sl < n ? (unsigned short)(8191u - (lists[qq * LC + sl] & 0x1fffu)) : (unsigned short)0; }
    if (lane == 0) NSEL[row] = (int)n;
  }
  __syncthreads();
}

__device__ __forceinline__ void sparse_attn_phase(LAS unsigned char* lds, const bf16_t* H, const unsigned short* SEL, const int* NSEL, bf16_t* MIX) {
  const int tid = threadIdx.x, lane = tid & 63, wid = __builtin_amdgcn_readfirstlane(tid >> 6), r = lane & 31, h = lane >> 5;
  const int gw = blockIdx.x * NWAVES + wid, NGW = gridDim.x * NWAVES;
  LAS unsigned char* vbuf = lds + wid * 8192;
  const int i16 = lane & 15, q4 = i16 >> 2, p4 = i16 & 3, g16 = (lane >> 4) & 1;
  const unsigned troff = (4 * h + q4) * 128 + (16 * g16 + 4 * p4) * 2;
  for (int row = gw; row < M; row += NGW) {
    const size_t rowbase = (size_t)(row >> 13) * SEQ;
    const int n = __builtin_amdgcn_readfirstlane(NSEL[row]);
    const int nt = (n + 31) >> 5;
    bf16x8 Bq[4];
#pragma unroll
    for (int ks = 0; ks < 4; ++ks) { bf16x8 v = ldg16(H + (size_t)row * HP + C_BQ + (r & 7) * 64 + 16 * ks + 8 * h); if (r >= 8) v = (bf16x8){0, 0, 0, 0, 0, 0, 0, 0}; Bq[ks] = v; }
    f32x16 O[2];
#pragma unroll
    for (int dt = 0; dt < 2; ++dt)
#pragma unroll
      for (int i = 0; i < 16; ++i) O[dt][i] = 0.f;
    float mx = -INFINITY, sum = 0.f;
    for (int tl = 0; tl < nt; ++tl) {
      LAS unsigned char* vb = vbuf + (tl & 1) * 4096;
      const int sl = 32 * tl + r; const int kidx = sl < n ? (int)SEL[(size_t)row * 256 + sl] : 0;
      bf16x8 A[4];
#pragma unroll
      for (int ks = 0; ks < 4; ++ks) A[ks] = ldg16(H + (rowbase + kidx) * HP + C_BK + 16 * ks + 8 * h);
      u32x4 vv[4];
#pragma unroll
      for (int i = 0; i < 4; ++i) {
        const int kl = (lane >> 3) + 8 * i, sv = 32 * tl + kl; const int kiv = sv < n ? (int)SEL[(size_t)row * 256 + sv] : 0;
        vv[i] = *(const u32x4*)(H + (rowbase + kiv) * HP + C_BV + (lane & 7) * 8);
      }
      f32x16 S;
#pragma unroll
      for (int i = 0; i < 16; ++i) S[i] = 0.f;
#pragma unroll
      for (int ks = 0; ks < 4; ++ks) S = MFMA32(A[ks], Bq[ks], S);
      float tm = -INFINITY;
#pragma unroll
      for (int i = 0; i < 16; ++i) { const bool valid = 32 * tl + crow(i, h) < n; S[i] = valid ? S[i] : -INFINITY; tm = fmaxf(tm, S[i]); }
      tm = fmaxf(tm, __shfl_xor(tm, 32));
      const float mn = fmaxf(mx, tm), corr = exp2f(mx - mn);
      mx = mn;
      float ps = 0.f;
#pragma unroll
      for (int i = 0; i < 16; ++i) { const float p = exp2f(S[i] - mn); S[i] = p; ps += p; }
      sum = sum * corr + ps;
#pragma unroll
      for (int dt = 0; dt < 2; ++dt)
#pragma unroll
        for (int i = 0; i < 16; ++i) O[dt][i] *= corr;
#pragma unroll
      for (int i = 0; i < 4; ++i) *(LAS u32x4*)(vb + ((lane >> 3) + 8 * i) * 128 + (lane & 7) * 16) = vv[i];
      LDSWAIT();
#pragma unroll
      for (int s = 0; s < 2; ++s) {
        const bf16x8 P = pack8(S, s);
#pragma unroll
        for (int dt = 0; dt < 2; ++dt) {
          LAS unsigned char* p = vb + troff + (16 * s) * 128 + dt * 64;
          const s16x4 lo = tr_read(p), hi = tr_read(p + 8 * 128);
          const bf16x8 A2 = __builtin_shufflevector(lo, hi, 0, 1, 2, 3, 4, 5, 6, 7);
          O[dt] = MFMA32(A2, P, O[dt]);
        }
      }
    }
    sum += __shfl_xor(sum, 32);
    const float rs = 1.0f / sum;
    if (r < 8) {
#pragma unroll
      for (int dt = 0; dt < 2; ++dt)
#pragma unroll
        for (int g4 = 0; g4 < 4; ++g4) {
          const int d = 32 * dt + 8 * g4 + 4 * h;
          const u32x2 gt = *(const u32x2*)(H + (size_t)row * HP + C_BG + r * 64 + d);
          const float o0 = O[dt][4 * g4 + 0] * rs * __uint_as_float(gt.x << 16), o1 = O[dt][4 * g4 + 1] * rs * __uint_as_float(gt.x & 0xffff0000u);
          const float o2 = O[dt][4 * g4 + 2] * rs * __uint_as_float(gt.y << 16), o3 = O[dt][4 * g4 + 3] * rs * __uint_as_float(gt.y & 0xffff0000u);
          u32x2 w; w.x = cvt_pk_bf16(o0, o1); w.y = cvt_pk_bf16(o2, o3);
          *(u32x2*)(MIX + (size_t)row * DM + 512 + r * 64 + d) = w;
        }
    }
    LDSWAIT();
  }
}

__device__ __forceinline__ float wave_sum(float v) {
#pragma unroll
  for (int o = 1; o < 64; o <<= 1) v += __shfl_xor(v, o);
  return v;
}
__device__ __forceinline__ void ln_phase(const float* Y, const float* g, const float* bta, float* out) {
  const int tid = threadIdx.x, lane = tid & 63, wid = tid >> 6;
  const int gw = blockIdx.x * NWAVES + wid, NGW = gridDim.x * NWAVES;
  f32x4 gv[4], bv[4];
#pragma unroll
  for (int j = 0; j < 4; ++j) { gv[j] = *(const f32x4*)(g + 4 * lane + 256 * j); bv[j] = *(const f32x4*)(bta + 4 * lane + 256 * j); }
  for (int row = gw; row < M; row += NGW) {
    const f32x4* yr = (const f32x4*)(Y + (size_t)row * DM) + lane;
    f32x4 v[4]; float s = 0.f;
#pragma unroll
    for (int j = 0; j < 4; ++j) { v[j] = yr[64 * j]; s += (v[j][0] + v[j][1]) + (v[j][2] + v[j][3]); }
    const float mean = wave_sum(s) * (1.f / DM); float s2 = 0.f;
#pragma unroll
    for (int j = 0; j < 4; ++j) { v[j] = v[j] - mean; s2 += (v[j][0] * v[j][0] + v[j][1] * v[j][1]) + (v[j][2] * v[j][2] + v[j][3] * v[j][3]); }
    const float rstd = 1.f / sqrtf(wave_sum(s2) * (1.f / DM) + LN_EPS);
    f32x4* o = (f32x4*)(out + (size_t)row * DM) + lane;
#pragma unroll
    for (int j = 0; j < 4; ++j) o[64 * j] = v[j] * rstd * gv[j] + bv[j];
  }
}

#define XB_TMO      128
#define XB_XCNT(j)  (256  + 64 * (j))
#define XB_XSUB(j)  (1280 + 64 * (j))
#define XB_XGEN(j)  (2304 + 64 * (j))
#define XB_TOP      3328
#define XB_TOPGEN   3392
#define XCD_BAR_WORDS 3456
#define XB_SPIN_CAP (1u << 18)

__device__ __forceinline__ unsigned xb_ld(unsigned* p)              { return __hip_atomic_load(p, __ATOMIC_RELAXED, __HIP_MEMORY_SCOPE_AGENT); }
__device__ __forceinline__ unsigned xb_add(unsigned* p, unsigned v) { return __hip_atomic_fetch_add(p, v, __ATOMIC_RELAXED, __HIP_MEMORY_SCOPE_AGENT); }
__device__ __forceinline__ unsigned xb_xcc_id() { return (unsigned)__builtin_amdgcn_s_getreg((3 << 11) | 20) & 0xFu; }
#define XB_SPIN(cond, bar) do { unsigned _sp = 0; while (cond) { __builtin_amdgcn_s_sleep(1); \
    if ((++_sp & 255u) == 0u) { if (xb_ld(&(bar)[XB_TMO])) break; if (_sp > XB_SPIN_CAP) { atomicAdd(&(bar)[XB_TMO], 1u); break; } } } } while (0)

struct XcdBarrier {
    unsigned* bar; unsigned x;
    volatile LAS unsigned* st;
};

__device__ __forceinline__ XcdBarrier xcd_barrier_post(unsigned* bar, volatile LAS unsigned* st) {
    XcdBarrier b; b.bar = bar; b.x = xb_xcc_id(); b.st = st;
    if (threadIdx.x == 0) (void)xb_add(&bar[XB_XCNT(b.x)], 1u);
    return b;
}
__device__ __forceinline__ void xcd_barrier_complete(unsigned* bar, unsigned x, unsigned& nloc, unsigned& nx) {
    const unsigned G = gridDim.x * gridDim.y * gridDim.z;
    unsigned sum, cnt, mine, sp = 0u;
    for (;;) {
        sum = 0u; cnt = 0u; mine = 0u;
#pragma unroll
        for (unsigned j = 0; j < 16; ++j) { const unsigned c = xb_ld(&bar[XB_XCNT(j)]); sum += c; cnt += (c > 0u) ? 1u : 0u; mine = (j == x) ? c : mine; }
        if (sum == G) break;
        __builtin_amdgcn_s_sleep(1);
        if ((++sp & 255u) == 0u) { if (xb_ld(&bar[XB_TMO])) break; if (sp > XB_SPIN_CAP) { atomicAdd(&bar[XB_TMO], 1u); break; } }
    }
    nloc = mine > 0u ? mine : 1u; nx = cnt > 0u ? cnt : 1u;
}

__device__ __forceinline__ void xcd_barrier(const XcdBarrier& b) {
    asm volatile("s_waitcnt vmcnt(0)" ::: "memory");
    __syncthreads();
    if (threadIdx.x == 0) {
        unsigned* bar = b.bar;
        __builtin_amdgcn_s_waitcnt(0);
        unsigned nloc = b.st[0], nx = b.st[1];
        if (nloc == 0u) { xcd_barrier_complete(bar, b.x, nloc, nx); b.st[0] = nloc; b.st[1] = nx; }
        const unsigned old = xb_add(&bar[XB_XSUB(b.x)], 1u);
        const unsigned gen = old / nloc;
        if (old + 1u == (gen + 1u) * nloc) {
            __builtin_amdgcn_fence(__ATOMIC_RELEASE, "agent");
            asm volatile("s_waitcnt vmcnt(0)" ::: "memory");
            const unsigned og = xb_add(&bar[XB_TOP], 1u);
            const unsigned tg = og / nx;
            if (og + 1u == (tg + 1u) * nx) xb_add(&bar[XB_TOPGEN], 1u);
            else XB_SPIN(xb_ld(&bar[XB_TOPGEN]) == tg, bar);
            __builtin_amdgcn_fence(__ATOMIC_ACQUIRE, "agent");
            xb_add(&bar[XB_XGEN(b.x)], 1u);
            asm volatile("s_waitcnt vmcnt(0)" ::: "memory");
        } else {
            XB_SPIN(xb_ld(&bar[XB_XGEN(b.x)]) == gen, bar);
            __builtin_amdgcn_fence(__ATOMIC_ACQUIRE, "agent");
            asm volatile("s_waitcnt vmcnt(0)" ::: "memory");
        }
    }
    __syncthreads();
}

#ifndef PHMASK
#define PHMASK 255
#endif
#ifndef REPMASK
#define REPMASK 0
#endif
__global__ void __launch_bounds__(NTHREADS, 2) hybrid_fwd(Args a) {
  extern __shared__ __attribute__((aligned(16))) unsigned char lds_raw[];
  LAS unsigned char* lds = (LAS unsigned char*)lds_raw;
  cg::grid_group grid = cg::this_grid();
  const int tid = threadIdx.x;
  if (a.ws == nullptr) grid.sync();
  bf16_t* BTIN = (bf16_t*)(a.ws + WS_BTIN); bf16_t* BTOUT = (bf16_t*)(a.ws + WS_BTOUT);
  bf16_t* XN = (bf16_t*)(a.ws + WS_XN); bf16_t* H = (bf16_t*)(a.ws + WS_H); bf16_t* MIX = (bf16_t*)(a.ws + WS_MIX);
  float* IW = (float*)(a.ws + WS_IW); float* YPRE = (float*)(a.ws + WS_YPRE);
  int* NSEL = (int*)(a.ws + WS_NSEL); unsigned short* SEL = (unsigned short*)(a.ws + WS_SEL);
  unsigned* ctl = (unsigned*)(a.ws + WS_CTL);
  volatile LAS unsigned* bst = (volatile LAS unsigned*)(lds + L_BAR);
  if (tid < 2) bst[tid] = 0u;
  __syncthreads();
  const XcdBarrier bar = xcd_barrier_post(ctl + 1024, bst);
  if (PHMASK & 1) for (int rep = 0; rep < ((REPMASK & 1) ? 2 : 1); ++rep) p0_prologue(a, lds);
  xcd_barrier(bar);
  if (PHMASK & 2) {
    pg8::Gemm g{XN, BTIN, M, NPAD, DM}; pg8::StaticOrder S; S.init(M, NPAD, (int)gridDim.x, (int)blockIdx.x);
    EpiInProj E{H, IW, a.b_in, (const f32x2*)(a.ws + WS_CS)};
    pg8::gemm_phase<EpiInProj, pg8::StaticOrder, true, true>(lds, g, S, E);
  }
  if (REPMASK & 2) {
    pg8::Gemm g{XN, BTIN, M, NPAD, DM}; pg8::StaticOrder S; S.init(M, NPAD, (int)gridDim.x, (int)blockIdx.x);
    EpiInProj E{H, IW, a.b_in, (const f32x2*)(a.ws + WS_CS)};
    pg8::gemm_phase<EpiInProj, pg8::StaticOrder, true, true>(lds, g, S, E);
  }
  xcd_barrier(bar);
  if (PHMASK & 4) {
    LAS int* us = (LAS int*)(lds + L_UNIT);
    if (PHMASK & 64) for (int rep = 0; rep < ((REPMASK & 64) ? 2 : 1); ++rep) for (;;) {
      if (tid == 0) *us = (int)__hip_atomic_fetch_add(ctl + 128 * rep, 1u, __ATOMIC_RELAXED, __HIP_MEMORY_SCOPE_AGENT);
      __syncthreads();
      const int u = *us;
      __syncthreads();
      if (u >= 512) break;
      indexer_unit(lds, u, H, IW, SEL, NSEL);
    }
    if (PHMASK & 128) for (int rep = 0; rep < ((REPMASK & 128) ? 2 : 1); ++rep) for (;;) {
      if (tid == 0) *us = (int)__hip_atomic_fetch_add(ctl + 64 + 128 * rep, 1u, __ATOMIC_RELAXED, __HIP_MEMORY_SCOPE_AGENT);
      __syncthreads();
      const int u = *us;
      __syncthreads();
      if (u >= 512) break;
      swa_unit(lds, u, H, a.sinks, MIX);
    }
  }
  xcd_barrier(bar);
  if (PHMASK & 8) for (int rep = 0; rep < ((REPMASK & 8) ? 2 : 1); ++rep) sparse_attn_phase(lds, H, SEL, NSEL, MIX);
  xcd_barrier(bar);
  if (PHMASK & 16) for (int rep = 0; rep < ((REPMASK & 16) ? 2 : 1); ++rep) {
    pg8::Gemm g{MIX, BTOUT, M, DM, DM}; pg8::StaticOrder S; S.init(M, DM, (int)gridDim.x, (int)blockIdx.x);
    EpiOutProj E{YPRE, a.b_out, a.x};
    pg8::gemm_phase<EpiOutProj, pg8::StaticOrder, true, true>(lds, g, S, E);
  }
  xcd_barrier(bar);
  if (PHMASK & 32) for (int rep = 0; rep < ((REPMASK & 32) ? 2 : 1); ++rep) ln_phase(YPRE, a.ln_g, a.ln_b, a.out);
}

extern "C" void kernel_launch(void* const* d_in, const int* in_sizes, int n_in, void* d_out, int out_size, void* d_ws, size_t ws_size, hipStream_t stream) {
  static int grid = 0;
  if (grid == 0) {
    if (n_in != 9 || ws_size < WS_END) { fprintf(stderr, "kernel_launch: unexpected inputs (n_in %d, ws %zu)\n", n_in, ws_size); grid = -1; return; }
    int dev = 0, cus = 0, per_cu = 0;
    (void)hipGetDevice(&dev); (void)hipDeviceGetAttribute(&cus, hipDeviceAttributeMultiprocessorCount, dev);
    if (hipFuncSetAttribute((const void*)hybrid_fwd, hipFuncAttributeMaxDynamicSharedMemorySize, LDS_BYTES) != hipSuccess) { fprintf(stderr, "kernel_launch: hipFuncSetAttribute failed\n"); grid = -1; return; }
    (void)hipOccupancyMaxActiveBlocksPerMultiprocessor(&per_cu, (const void*)hybrid_fwd, NTHREADS, LDS_BYTES);
    if (per_cu < 1) { fprintf(stderr, "kernel_launch: occupancy query says %d blocks per CU\n", per_cu); per_cu = 1; }
    (void)hipGetLastError();
    grid = cus;
  }
  if (grid < 0) return;
  (void)hipMemsetAsync((char*)d_ws + WS_CTL, 0, 32768, stream);
  Args a{};
  a.x = (const float*)d_in[0]; a.pos = (const int*)d_in[1]; a.w_in = (const float*)d_in[2]; a.b_in = (const float*)d_in[3]; a.sinks = (const float*)d_in[4];
  a.w_out = (const float*)d_in[5]; a.b_out = (const float*)d_in[6]; a.ln_g = (const float*)d_in[7]; a.ln_b = (const float*)d_in[8];
  a.out = (float*)d_out; a.ws = (unsigned char*)d_ws;
  void* args[] = {&a};
  hipError_t e = hipLaunchCooperativeKernel((const void*)hybrid_fwd, dim3(grid), dim3(NTHREADS), args, LDS_BYTES, stream);
  if (e != hipSuccess) fprintf(stderr, "kernel_launch: cooperative launch failed: %s (grid %d)\n", hipGetErrorString(e), grid);
}
```

```cpp
#include <hip/hip_runtime.h>
#include <hip/hip_cooperative_groups.h>
#include <cstdio>
#include <cstdint>
namespace cg = cooperative_groups;
namespace pg8 {
#define PG8_LAS __attribute__((address_space(3)))
typedef unsigned short bf16_t;
typedef short bf16x8 __attribute__((ext_vector_type(8)));
typedef float f32x4 __attribute__((ext_vector_type(4)));
typedef unsigned u32x4 __attribute__((ext_vector_type(4)));
constexpr int BM = 256, BK = 64, HALF = 128, HTB = HALF * BK * 2  , STAGE_BYTES = 8 * HTB, NXCD = 8, WGM = 8;

__host__ __device__ __forceinline__ int lds_byte(int r, int c) { const int st = (r >> 4) * 2 + (c >> 5), rr = r & 15, cc = c & 31, ob = rr * 64 + cc * 2; return st * 1024 + (ob ^ (((ob >> 9) & 1) << 5)); }
__host__ __device__ __forceinline__ void stage_rc(int b, int& R, int& C) { const int st = b / 1024, sb = b % 1024, swz = sb ^ (((sb >> 9) & 1) << 5); R = (st >> 1) * 16 + swz / 64; C = (st & 1) * 32 + (swz % 64) / 2; }
__host__ __device__ __forceinline__ int perm32(int rho) { const int n = rho >> 4, i = rho & 15; return 8 * (i >> 2) + 4 * n + (i & 3); }

struct Unit { int pm, pn; };
struct Gemm { const bf16_t* A; const bf16_t* Bt; int M, N, K; };

struct StaticOrder {
    int nM, nN, nwg, G, c;
    __host__ __device__ void init(int M, int N, int G_, int c_) { nM = M / BM; nN = N / BM; nwg = nM * nN; G = G_; c = c_; }
    __host__ __device__ bool next(int i, Unit& u) const {
        const long L = (long)i * G + c; if (L >= nwg) return false;
        int wgid = (int)L; { const int q = nwg / NXCD, r = nwg % NXCD, xcd = wgid % NXCD, off = wgid / NXCD; wgid = (xcd < r ? xcd * (q + 1) : r * (q + 1) + (xcd - r) * q) + off; }
        const int nig = WGM * nN, gid = wgid / nig, fm = gid * WGM, gsz = (nM - fm) < WGM ? (nM - fm) : WGM;
        u.pm = fm + ((wgid % nig) % gsz); u.pn = (wgid % nig) / gsz; return true;
    }
    __device__ __forceinline__ void a_ready(const Unit&) const {}
    __device__ __forceinline__ void done(const Unit&) const {}
};

__device__ __forceinline__ unsigned cvt_pk_bf16(float lo, float hi) { unsigned r; asm volatile("v_cvt_pk_bf16_f32 %0, %1, %2" : "=v"(r) : "v"(lo), "v"(hi)); return r; }
template <class Epi, class Sched, bool ALIGN_EPI = false, bool SP2 = false>
__device__ __forceinline__ void gemm_phase(PG8_LAS unsigned char* lds, const Gemm g, const Sched& S, const Epi& E) {
    const int tid = threadIdx.x, wid = __builtin_amdgcn_readfirstlane(tid >> 6), lane = tid & 63, wr = wid >> 2, wc = wid & 3, fr = lane & 15, fq = lane >> 4;
    const int K = g.K, nt = K / BK;
    unsigned voffA[2], voffB[2];
#pragma unroll
    for (int i = 0; i < 2; ++i) { int R, C; stage_rc(tid * 16 + i * 8192, R, C); const int Rb = Epi::PERM ? ((R & ~31) + perm32(R & 31)) : R;
        voffA[i] = (unsigned)(R * K + C) * 2u; voffB[i] = (unsigned)(Rb * K + C) * 2u; }
    const size_t kstep = (size_t)(BK * 2);
    const size_t hstep = (size_t)HALF * K * 2;
    const size_t tstep = 2 * hstep;
    const unsigned ldsw = (unsigned)wid * 1024u;
    const int aoff = lds_byte(wr * 64 + fr, fq * 8), boff = lds_byte(wc * 32 + fr, fq * 8);
#define PG8_SA(b, h) (((b) * 2 + (h)) * HTB)
#define PG8_SB(b, h) ((4 + (b) * 2 + (h)) * HTB)
#define PG8_STAGE(bufoff, gbase, voff) do { _Pragma("unroll") for (int _i = 0; _i < 2; ++_i) \
        __builtin_amdgcn_global_load_lds((const unsigned*)((const char*)(gbase) + (voff)[_i]), (PG8_LAS unsigned*)(lds + (bufoff) + ldsw + _i * 8192), 16, 0, 0); } while (0)
#define PG8_LDA(dst, b, h) do { _Pragma("unroll") for (int m = 0; m < 4; ++m) _Pragma("unroll") for (int k = 0; k < 2; ++k) dst[m][k] = *(const PG8_LAS bf16x8*)(lds + PG8_SA(b, h) + aoff + m * 2048 + k * 1024); } while (0)
#define PG8_LDB(dst, b, h) do { _Pragma("unroll") for (int n = 0; n < 2; ++n) _Pragma("unroll") for (int k = 0; k < 2; ++k) dst[n][k] = *(const PG8_LAS bf16x8*)(lds + PG8_SB(b, h) + boff + n * 2048 + k * 1024); } while (0)
#define PG8_MMA(ai, bj, At, Bt) do { __builtin_amdgcn_s_setprio(1); _Pragma("unroll") for (int m = 0; m < 4; ++m) _Pragma("unroll") for (int n = 0; n < 2; ++n) _Pragma("unroll") for (int k = 0; k < 2; ++k) \
        acc[ai][bj][m][n] = __builtin_amdgcn_mfma_f32_16x16x32_bf16(Bt[n][k], At[m][k], acc[ai][bj][m][n], 0, 0, 0); __builtin_amdgcn_s_setprio(0); } while (0)
#define PG8_WAIT_V(n) asm volatile("s_waitcnt vmcnt(" #n ")" ::: "memory")
#define PG8_WAIT_L(n) asm volatile("s_waitcnt lgkmcnt(" #n ")" ::: "memory")
#define PG8_BAR __builtin_amdgcn_s_barrier()
#define PG8_SCHED __builtin_amdgcn_sched_barrier(0)
    Unit cur, nxt; int ui = 0;
    if (!S.next(0, cur)) return;
    f32x4 acc[2][2][4][2];
#pragma unroll
    for (int a = 0; a < 2; ++a)
#pragma unroll
        for (int b = 0; b < 2; ++b)
#pragma unroll
            for (int m = 0; m < 4; ++m)
#pragma unroll
                for (int n = 0; n < 2; ++n) acc[a][b][m][n] = (f32x4){0.f, 0.f, 0.f, 0.f};
    bf16x8 At[4][2], B0[2][2], B1[2][2];
    const char* cA = (const char*)g.A + (size_t)cur.pm * tstep; const char* cB = (const char*)g.Bt + (size_t)cur.pn * tstep;
    S.a_ready(cur);
    if constexpr (SP2) {
        PG8_STAGE(PG8_SB(0, 0), cB, voffB); PG8_STAGE(PG8_SB(0, 1), cB + hstep, voffB); PG8_STAGE(PG8_SA(0, 0), cA, voffA); PG8_STAGE(PG8_SA(0, 1), cA + hstep, voffA);
        if (wr == 1) PG8_BAR;
        PG8_WAIT_V(2); PG8_BAR;
        PG8_STAGE(PG8_SB(1, 0), cB + kstep, voffB); PG8_STAGE(PG8_SA(1, 0), cA + kstep, voffA); PG8_STAGE(PG8_SB(1, 1), cB + hstep + kstep, voffB);
        PG8_WAIT_V(6); PG8_BAR;
    } else {
        PG8_STAGE(PG8_SB(0, 0), cB, voffB); PG8_STAGE(PG8_SA(0, 0), cA, voffA); PG8_STAGE(PG8_SB(0, 1), cB + hstep, voffB); PG8_STAGE(PG8_SA(0, 1), cA + hstep, voffA);
        if (wr == 1) PG8_BAR;
        PG8_WAIT_V(4); PG8_BAR;
        PG8_STAGE(PG8_SB(1, 0), cB + kstep, voffB); PG8_STAGE(PG8_SA(1, 0), cA + kstep, voffA); PG8_STAGE(PG8_SB(1, 1), cB + hstep + kstep, voffB);
        PG8_WAIT_V(6); PG8_BAR;
    }
    for (;;) {
        const bool has_next = S.next(ui + 1, nxt);
        const char* nA = has_next ? (const char*)g.A + (size_t)nxt.pm * tstep : cA; const char* nB = has_next ? (const char*)g.Bt + (size_t)nxt.pn * tstep : cB;
        for (int t = 0; t < nt; t += 2) {
            const bool last = (t == nt - 2);
            const char* a1 = cA + (size_t)(t + 1) * kstep;
            const char* a2 = last ? nA : cA + (size_t)(t + 2) * kstep; const char* b2 = last ? nB : cB + (size_t)(t + 2) * kstep;
            const char* a3 = a2 + kstep; const char* b3 = b2 + kstep;
            if (last && has_next) S.a_ready(nxt);
            if constexpr (SP2) {
            PG8_LDB(B0, 0, 0); PG8_LDB(B1, 0, 1); PG8_SCHED; PG8_LDA(At, 0, 0); PG8_STAGE(PG8_SA(1, 1), a1 + hstep, voffA);
            PG8_WAIT_V(8); PG8_WAIT_L(0); PG8_BAR; PG8_MMA(0, 0, At, B0); PG8_MMA(0, 1, At, B1); PG8_BAR; PG8_SCHED;
            PG8_LDA(At, 0, 1); PG8_STAGE(PG8_SB(0, 0), b2, voffB); PG8_STAGE(PG8_SB(0, 1), b2 + hstep, voffB); PG8_STAGE(PG8_SA(0, 0), a2, voffA);
            PG8_WAIT_V(8); PG8_WAIT_L(0); PG8_BAR; PG8_MMA(1, 0, At, B0); PG8_MMA(1, 1, At, B1); PG8_BAR; PG8_SCHED;
            PG8_LDB(B0, 1, 0); PG8_LDB(B1, 1, 1); PG8_SCHED; PG8_LDA(At, 1, 0); PG8_STAGE(PG8_SA(0, 1), a2 + hstep, voffA);
            PG8_WAIT_V(8); PG8_WAIT_L(0); PG8_BAR; PG8_MMA(0, 0, At, B0); PG8_MMA(0, 1, At, B1); PG8_BAR; PG8_SCHED;
            PG8_LDA(At, 1, 1); PG8_STAGE(PG8_SB(1, 0), b3, voffB); PG8_STAGE(PG8_SB(1, 1), b3 + hstep, voffB); PG8_STAGE(PG8_SA(1, 0), a3, voffA);
            PG8_WAIT_V(8); PG8_WAIT_L(0); PG8_BAR; PG8_MMA(1, 0, At, B0); PG8_MMA(1, 1, At, B1); PG8_BAR; PG8_SCHED;
            } else {
            PG8_LDB(B0, 0, 0); PG8_SCHED; PG8_LDA(At, 0, 0); PG8_STAGE(PG8_SA(1, 1), a1 + hstep, voffA);
            PG8_WAIT_L(8); PG8_BAR; PG8_WAIT_L(0); PG8_MMA(0, 0, At, B0); PG8_BAR; PG8_SCHED;
            PG8_LDB(B1, 0, 1); PG8_STAGE(PG8_SB(0, 0), b2, voffB);
            PG8_BAR; PG8_WAIT_L(0); PG8_MMA(0, 1, At, B1); PG8_BAR;
            PG8_LDA(At, 0, 1); PG8_STAGE(PG8_SA(0, 0), a2, voffA);
            PG8_BAR; PG8_WAIT_L(0); PG8_MMA(1, 0, At, B0); PG8_BAR; PG8_SCHED;
            PG8_STAGE(PG8_SB(0, 1), b2 + hstep, voffB);
            PG8_WAIT_V(6); PG8_BAR; PG8_MMA(1, 1, At, B1); PG8_BAR;
            PG8_LDB(B0, 1, 0); PG8_SCHED; PG8_LDA(At, 1, 0); PG8_STAGE(PG8_SA(0, 1), a2 + hstep, voffA);
            PG8_WAIT_L(8); PG8_BAR; PG8_WAIT_L(0); PG8_MMA(0, 0, At, B0); PG8_BAR; PG8_SCHED;
            PG8_LDB(B1, 1, 1); PG8_STAGE(PG8_SB(1, 0), b3, voffB);
            PG8_BAR; PG8_WAIT_L(0); PG8_MMA(0, 1, At, B1); PG8_BAR;
            PG8_LDA(At, 1, 1); PG8_STAGE(PG8_SA(1, 0), a3, voffA);
            PG8_BAR; PG8_WAIT_L(0); PG8_MMA(1, 0, At, B0); PG8_BAR; PG8_SCHED;
            PG8_STAGE(PG8_SB(1, 1), b3 + hstep, voffB);
            PG8_WAIT_V(6); PG8_BAR; PG8_MMA(1, 1, At, B1); PG8_BAR;
            }
        }
        if constexpr (ALIGN_EPI) { if (wr == 0) PG8_BAR; }
        if constexpr (!Epi::AFTER_DRAIN) { E(acc, cur, wr, wc, fr, fq); S.done(cur); }
        if (!has_next) break;
#pragma unroll
        for (int a = 0; a < 2; ++a)
#pragma unroll
            for (int b = 0; b < 2; ++b)
#pragma unroll
                for (int m = 0; m < 4; ++m)
#pragma unroll
                    for (int n = 0; n < 2; ++n) acc[a][b][m][n] = (f32x4){0.f, 0.f, 0.f, 0.f};
        cur = nxt; cA = nA; cB = nB; ++ui;
        if constexpr (ALIGN_EPI) { if (wr == 1) PG8_BAR; }
    }
    PG8_WAIT_V(0);
    if constexpr (!ALIGN_EPI) { if (wr == 0) PG8_BAR; }
    PG8_BAR;
    if constexpr (Epi::AFTER_DRAIN) { E.fused(acc, cur, wr, wc, fr, fq, lds, wid, lane); S.done(cur); }
#undef PG8_SA
#undef PG8_SB
#undef PG8_STAGE
#undef PG8_LDA
#undef PG8_LDB
#undef PG8_MMA
#undef PG8_WAIT_V
#undef PG8_WAIT_L
#undef PG8_BAR
#undef PG8_SCHED
}
}
#define LAS __attribute__((address_space(3)))
typedef unsigned short bf16_t;
typedef short bf16x8 __attribute__((ext_vector_type(8)));
typedef short s16x4 __attribute__((ext_vector_type(4)));
typedef float f32x4 __attribute__((ext_vector_type(4)));
typedef float f32x2 __attribute__((ext_vector_type(2)));
typedef float f32x16 __attribute__((ext_vector_type(16)));
typedef unsigned u32x4 __attribute__((ext_vector_type(4)));
typedef unsigned u32x2 __attribute__((ext_vector_type(2)));
using pg8::cvt_pk_bf16;

constexpr int SEQ = 8192, NB = 2, M = NB * SEQ, DM = 1024, NCOL = 2756, NPAD = 2816, HP = 2752;
constexpr int C_AQ = 0, C_AK = 512, C_AV = 640, C_AG = 768, C_BQ = 1280, C_BK = 1792, C_BV = 1856, C_BG = 1920, C_IQ = 2432, C_IK = 2688, C_IW = 2752;
constexpr float LOG2E = 1.4426950408889634f, QSCALE = 0.125f * LOG2E, LN_EPS = 1e-5f;
constexpr float ALPHA = 1.189207115002721f;
constexpr size_t MiB = 1u << 20;
constexpr size_t WS_CTL = 0, WS_BTIN = 2 * MiB, WS_BTOUT = 8 * MiB, WS_CS = 10 * MiB, WS_IW = 14 * MiB, WS_NSEL = 15 * MiB, WS_SEL = 16 * MiB,
                 WS_XN = 24 * MiB, WS_H = 56 * MiB, WS_MIX = 142 * MiB, WS_YPRE = 174 * MiB, WS_END = 238 * MiB;
constexpr int LDS_BYTES = 147456;
constexpr int NTHREADS = 512, NWAVES = 8;
#define MFMA32(a, b, c) __builtin_amdgcn_mfma_f32_32x32x16_bf16((a), (b), (c), 0, 0, 0)
#define LDSWAIT() asm volatile("s_waitcnt lgkmcnt(0)" ::: "memory")

__device__ __forceinline__ int crow(int i, int h) { return (i & 3) + 8 * (i >> 2) + 4 * h; }
__device__ __forceinline__ int swap45(int c) { return (c & ~48) | ((c & 16) << 1) | ((c & 32) >> 1); }
__device__ __forceinline__ float bf2f(unsigned short b) { return __uint_as_float((unsigned)b << 16); }
__device__ __forceinline__ bf16x8 ldg16(const bf16_t* p) { return *(const bf16x8*)p; }
__device__ __forceinline__ bf16x8 pack8(const f32x16& x, int s) {
  u32x4 p; p.x = cvt_pk_bf16(x[8 * s + 0], x[8 * s + 1]); p.y = cvt_pk_bf16(x[8 * s + 2], x[8 * s + 3]); p.z = cvt_pk_bf16(x[8 * s + 4], x[8 * s + 5]); p.w = cvt_pk_bf16(x[8 * s + 6], x[8 * s + 7]);
  return __builtin_bit_cast(bf16x8, p);
}
__device__ __forceinline__ float relu1(float x) { return __builtin_amdgcn_fmed3f(x, 0.f, __builtin_inff()); }
__device__ __forceinline__ s16x4 tr_read(LAS unsigned char* p) { return __builtin_amdgcn_ds_read_tr16_b64_v4i16((LAS s16x4*)p); }

struct Args { const float* x; const int* pos; const float* w_in; const float* b_in; const float* sinks; const float* w_out; const float* b_out; const float* ln_g; const float* ln_b;
              float* out; unsigned char* ws; };

__device__ __forceinline__ void p0_transpose_item(const float* W, int N, bf16_t* WT, bool perm, LAS float* scr, int item, int nblk, int lane) {
  const int kb = item / nblk, nb = item % nblk, k0 = 64 * kb, n0 = 32 * nb;
  const int nn = n0 + (lane & 31);
#pragma unroll 8
  for (int i = 0; i < 32; ++i) { const int kk = 2 * i + (lane >> 5); scr[kk * 33 + (lane & 31)] = nn < N ? W[(size_t)(k0 + kk) * N + nn] : 0.f; }
  LDSWAIT();
  const int c = lane & 7;
#pragma unroll
  for (int j = 0; j < 4; ++j) { const int n = (lane >> 3) + 8 * j; const LAS float* s = scr + (8 * c) * 33 + n;
    u32x4 o; o.x = cvt_pk_bf16(s[0 * 33], s[1 * 33]); o.y = cvt_pk_bf16(s[2 * 33], s[3 * 33]); o.z = cvt_pk_bf16(s[4 * 33], s[5 * 33]); o.w = cvt_pk_bf16(s[6 * 33], s[7 * 33]);
    const int grow = perm ? swap45(n0 + n) : (n0 + n);
    *(u32x4*)(WT + (size_t)grow * 1024 + k0 + 8 * c) = o; }
  LDSWAIT();
}
__device__ __forceinline__ void p0_prologue(const Args& a, LAS unsigned char* lds) {
  const int tid = threadIdx.x, lane = tid & 63, wid = tid >> 6;
  const int gw = blockIdx.x * NWAVES + wid, NGW = gridDim.x * NWAVES;
  LAS float* scr = (LAS float*)(lds + wid * 16384);
  bf16_t* BTIN = (bf16_t*)(a.ws + WS_BTIN); bf16_t* BTOUT = (bf16_t*)(a.ws + WS_BTOUT);
  constexpr int NBI = NPAD / 32, I_IN = 16 * NBI, I_OUT = 16 * 32;
  for (int it = gw; it < I_IN + I_OUT; it += NGW) {
    if (it < I_IN) p0_transpose_item(a.w_in, NCOL, BTIN, true, scr, it, NBI, lane);
    else p0_transpose_item(a.w_out, DM, BTOUT, false, scr, it - I_IN, 32, lane);
  }
  const int gt = blockIdx.x * NTHREADS + tid, NGT = gridDim.x * NTHREADS;
  bf16_t* XN = (bf16_t*)(a.ws + WS_XN);
  for (int i = gt; i < M * DM / 8; i += NGT) {
    const f32x4 v0 = *(const f32x4*)(a.x + (size_t)i * 8), v1 = *(const f32x4*)(a.x + (size_t)i * 8 + 4);
    u32x4 o; o.x = cvt_pk_bf16(v0[0], v0[1]); o.y = cvt_pk_bf16(v0[2], v0[3]); o.z = cvt_pk_bf16(v1[0], v1[1]); o.w = cvt_pk_bf16(v1[2], v1[3]);
    *(u32x4*)(XN + (size_t)i * 8) = o;
  }
  f32x2* CS = (f32x2*)(a.ws + WS_CS);
  for (int i = gt; i < M * 32; i += NGT) {
    const int row = i >> 5, j = i & 31;
    const float inv = exp2f(-(float)j * (13.287712379549449f / 32.0f));
    const float ang = (float)a.pos[row] * inv;
    CS[i] = (f32x2){cosf(ang), sinf(ang)};
  }
}

struct EpiInProj {
  static constexpr bool PERM = false, AFTER_DRAIN = false;
  bf16_t* H; float* IW; const float* bias; const f32x2* CS;
  __device__ __forceinline__ void operator()(const f32x4 (&acc)[2][2][4][2], const pg8::Unit& u, int wr, int wc, int fr, int fq) const {
    const int row0 = u.pm * 256 + wr * 64 + fr;
    const int dloc = 16 * (wc & 1) + 4 * fq;
#pragma unroll
    for (int bj = 0; bj < 2; ++bj) {
      const int G = 4 * u.pn + 2 * bj + (wc >> 1);
      if (G >= 44) continue;
      const int col1 = 64 * G + dloc;
      if (G == 43) {
        if (dloc == 0) {
          const f32x4 b1 = *(const f32x4*)(bias + col1);
#pragma unroll
          for (int ai = 0; ai < 2; ++ai)
#pragma unroll
            for (int m = 0; m < 4; ++m) { const int row = row0 + 128 * ai + 16 * m; *(f32x4*)(IW + (size_t)row * 4) = (acc[ai][bj][m][0] + b1) * 0.0625f; }
        }
        continue;
      }
      const f32x4 b1 = *(const f32x4*)(bias + col1), b2 = *(const f32x4*)(bias + col1 + 32);
      const bool rope = (G < 10) || (G >= 20 && G < 29) || (G >= 38);
      const bool silu = (G >= 12 && G < 20) || (G >= 30 && G < 38);
      const float sc = ((G < 8) || (G >= 20 && G < 28)) ? QSCALE : 1.0f;
#pragma unroll
      for (int ai = 0; ai < 2; ++ai)
#pragma unroll
        for (int m = 0; m < 4; ++m) {
          const int row = row0 + 128 * ai + 16 * m;
          f32x4 v1 = acc[ai][bj][m][0] + b1, v2 = acc[ai][bj][m][1] + b2;
          if (rope) {
            const f32x4 cs0 = *(const f32x4*)((const float*)CS + ((size_t)row * 32 + dloc) * 2), cs1 = *(const f32x4*)((const float*)CS + ((size_t)row * 32 + dloc) * 2 + 4);
            const f32x4 c = {cs0[0], cs0[2], cs1[0], cs1[2]}, s = {cs0[1], cs0[3], cs1[1], cs1[3]};
            const f32x4 o1 = v1 * c - v2 * s, o2 = v2 * c + v1 * s;
            v1 = o1 * sc; v2 = o2 * sc;
          } else if (silu) {
#pragma unroll
            for (int i = 0; i < 4; ++i) { v1[i] = v1[i] / (1.0f + __expf(-v1[i])); v2[i] = v2[i] / (1.0f + __expf(-v2[i])); }
          }
          u32x2 w1, w2; w1.x = cvt_pk_bf16(v1[0], v1[1]); w1.y = cvt_pk_bf16(v1[2], v1[3]); w2.x = cvt_pk_bf16(v2[0], v2[1]); w2.y = cvt_pk_bf16(v2[2], v2[3]);
          bf16_t* p = H + (size_t)row * HP + col1;
          *(u32x2*)p = w1; *(u32x2*)(p + 32) = w2;
        }
    }
  }
};
struct EpiOutProj {
  static constexpr bool PERM = false, AFTER_DRAIN = false;
  float* Y; const float* bias; const float* x;
  __device__ __forceinline__ void operator()(const f32x4 (&acc)[2][2][4][2], const pg8::Unit& u, int wr, int wc, int fr, int fq) const {
    const int row0 = u.pm * 256 + wr * 64 + fr, col0 = u.pn * 256 + wc * 32 + 4 * fq;
#pragma unroll
    for (int bj = 0; bj < 2; ++bj)
#pragma unroll
      for (int n = 0; n < 2; ++n) { const int col = col0 + 128 * bj + 16 * n; const f32x4 bv = *(const f32x4*)(bias + col);
#pragma unroll
        for (int ai = 0; ai < 2; ++ai)
#pragma unroll
          for (int m = 0; m < 4; ++m) { const size_t off = (size_t)(row0 + 128 * ai + 16 * m) * DM + col;
            *(f32x4*)(Y + off) = acc[ai][bj][m][n] + bv + ALPHA * *(const f32x4*)(x + off); } }
  }
};
__device__ __forceinline__ void swa_unit(LAS unsigned char* lds, int u, const bf16_t* H, const float* sinks, bf16_t* MIX) {
  const int tid = threadIdx.x, lane = tid & 63, wid = __builtin_amdgcn_readfirstlane(tid >> 6), r = lane & 31, h = lane >> 5;
  const int g = u & 1, qb = (u >> 1) & 127, b = u >> 8;
  const size_t rowbase = (size_t)b * SEQ;
  const int t00 = qb * 64, kbase = t00 - 128;
  for (int i = tid; i < 192 * 8; i += NTHREADS) {
    const int kl = i >> 3, piece = i & 7, key = kbase + kl;
    u32x4 v = {0u, 0u, 0u, 0u};
    if (key >= 0) v = *(const u32x4*)(H + (rowbase + key) * HP + C_AV + g * 64 + piece * 8);
    *(LAS u32x4*)(lds + kl * 128 + piece * 16) = v;
  }
  __syncthreads();
  const int r4 = wid & 3, sub = wid >> 2, hq = g * 4 + r4, t0 = t00 + 32 * sub;
  bf16x8 Bq[4];
#pragma unroll
  for (int ks = 0; ks < 4; ++ks) Bq[ks] = ldg16(H + (rowbase + t0 + r) * HP + C_AQ + hq * 64 + 16 * ks + 8 * h);
  f32x16 S[5];
#pragma unroll
  for (int tl = 0; tl < 5; ++tl) {
    const int key = t0 - 128 + 32 * tl + r, kc = key < 0 ? 0 : key;
    f32x16 acc;
#pragma unroll
    for (int i = 0; i < 16; ++i) acc[i] = 0.f;
#pragma unroll
    for (int ks = 0; ks < 4; ++ks) { const bf16x8 A = ldg16(H + (rowbase + kc) * HP + C_AK + g * 64 + 16 * ks + 8 * h); acc = MFMA32(A, Bq[ks], acc); }
    S[tl] = acc;
  }
  const float sk = sinks[hq] * LOG2E;
  float mx = sk;
#pragma unroll
  for (int tl = 0; tl < 5; ++tl)
#pragma unroll
    for (int i = 0; i < 16; ++i) {
      const int rel = r + 128 - 32 * tl - crow(i, h), key = t0 + r - rel;
      const bool valid = rel >= 0 && rel < 128 && key >= 0;
      S[tl][i] = valid ? S[tl][i] : -INFINITY;
      mx = fmaxf(mx, S[tl][i]);
    }
  mx = fmaxf(mx, __shfl_xor(mx, 32));
  float sum = 0.f;
#pragma unroll
  for (int tl = 0; tl < 5; ++tl)
#pragma unroll
    for (int i = 0; i < 16; ++i) { const float p = exp2f(S[tl][i] - mx); S[tl][i] = p; sum += p; }
  sum += __shfl_xor(sum, 32);
  sum += exp2f(sk - mx);
  const float rs = 1.0f / sum;
  f32x16 O[2];
#pragma unroll
  for (int dt = 0; dt < 2; ++dt)
#pragma unroll
    for (int i = 0; i < 16; ++i) O[dt][i] = 0.f;
  const int i16 = lane & 15, q4 = i16 >> 2, p4 = i16 & 3, g16 = (lane >> 4) & 1;
  LAS unsigned char* vb = lds + (32 * sub + 4 * h + q4) * 128 + (16 * g16 + 4 * p4) * 2;
#pragma unroll
  for (int tl = 0; tl < 5; ++tl)
#pragma unroll
    for (int s = 0; s < 2; ++s) {
      const bf16x8 P = pack8(S[tl], s);
#pragma unroll
      for (int dt = 0; dt < 2; ++dt) {
        LAS unsigned char* p = vb + (32 * tl + 16 * s) * 128 + dt * 64;
        const s16x4 lo = tr_read(p), hi = tr_read(p + 8 * 128);
        const bf16x8 A2 = __builtin_shufflevector(lo, hi, 0, 1, 2, 3, 4, 5, 6, 7);
        O[dt] = MFMA32(A2, P, O[dt]);
      }
    }
  const size_t row = rowbase + t0 + r;
#pragma unroll
  for (int dt = 0; dt < 2; ++dt)
#pragma unroll
    for (int g4 = 0; g4 < 4; ++g4) {
      const int d = 32 * dt + 8 * g4 + 4 * h;
      const u32x2 gt = *(const u32x2*)(H + row * HP + C_AG + hq * 64 + d);
      const float o0 = O[dt][4 * g4 + 0] * rs * __uint_as_float(gt.x << 16), o1 = O[dt][4 * g4 + 1] * rs * __uint_as_float(gt.x & 0xffff0000u);
      const float o2 = O[dt][4 * g4 + 2] * rs * __uint_as_float(gt.y << 16), o3 = O[dt][4 * g4 + 3] * rs * __uint_as_float(gt.y & 0xffff0000u);
      u32x2 w; w.x = cvt_pk_bf16(o0, o1); w.y = cvt_pk_bf16(o2, o3);
      *(u32x2*)(MIX + row * DM + hq * 64 + d) = w;
    }
  __syncthreads();
}

constexpr int LC = 768, L_SCR = 98304, L_HIST = 135168, L_CNT = 143360, L_TAU = 143488, L_WL = 143616, L_UNIT = 144128, L_BAR = 144256;
__device__ __forceinline__ void radix_pass2(LAS unsigned* L, unsigned n, LAS unsigned* hist, int shift_hi, unsigned& prefix, unsigned& mask, unsigned& kk, unsigned& kept, int lane) {
#pragma unroll 1
  for (int p = 0; p < 2; ++p) {
    const int shift = shift_hi - 8 * p;
    *(LAS u32x4*)(hist + 4 * lane) = (u32x4){0u, 0u, 0u, 0u};
    LDSWAIT();
    for (unsigned i = 4u * lane; i < n; i += 256u) {
      const u32x4 e4 = *(LAS u32x4*)(L + i);
#pragma unroll
      for (int j = 0; j < 4; ++j) { const unsigned e = e4[j]; if (i + j < n && (e & mask) == prefix) __hip_atomic_fetch_add(hist + ((e >> shift) & 255u), 1u, __ATOMIC_RELAXED, __HIP_MEMORY_SCOPE_WORKGROUP); }
    }
    LDSWAIT();
    const u32x4 hb = *(LAS u32x4*)(hist + 4 * lane);
    const unsigned s4 = hb.x + hb.y + hb.z + hb.w;
    unsigned incl = s4;
#pragma unroll
    for (int o = 1; o < 64; o <<= 1) { const unsigned t = __shfl_down(incl, o); if (lane + o < 64) incl += t; }
    unsigned run = incl - s4;
    bool found = false; unsigned Bl = 0u, abl = 0u, bcl = 0u;
#pragma unroll
    for (int bb = 3; bb >= 0; --bb) { const unsigned c = hb[bb]; if (!found && run < kk && run + c >= kk) { found = true; Bl = 4u * lane + bb; abl = run; bcl = c; } run += c; }
    const unsigned long long fm = __ballot(found);
    const int src = __ffsll((long long)fm) - 1;
    const unsigned B = __shfl(Bl, src), above = __shfl(abl, src), bc = __shfl(bcl, src);
    prefix |= B << shift; mask |= 255u << shift;
    kept = (256u - kk) + above + bc;
    kk -= above;
  }
}
__device__ __forceinline__ unsigned compact_ge(LAS unsigned* L, unsigned n, unsigned prefix, int lane) {
  unsigned off = 0u;
  for (unsigned base = 0; base < n; base += 64) {
    const unsigned i = base + lane; const unsigned e = (i < n) ? L[i] : 0u; const bool keep = (i < n) && (e >= prefix);
    const unsigned long long km = __ballot(keep);
    const unsigned pos = off + (unsigned)__popcll(km & ((1ull << lane) - 1ull));
    if (keep) L[pos] = e;
    off += (unsigned)__popcll(km);
  }
  LDSWAIT();
  return off;
}
__device__ __forceinline__ void select_compact(LAS unsigned* L, unsigned n, LAS unsigned* hist, unsigned limit, LAS unsigned* cntp, LAS float* taup, int lane) {
  unsigned prefix = 0u, mask = 0u, kk = 256u, kept = n;
  radix_pass2(L, n, hist, 24, prefix, mask, kk, kept, lane);
  unsigned n1 = compact_ge(L, n, prefix, lane);
  if (n1 > limit) {
    radix_pass2(L, n1, hist, 8, prefix, mask, kk, kept, lane);
    n1 = compact_ge(L, n1, prefix, lane);
  }
  if (lane == 0) {
    const unsigned p19 = prefix & 0xffffe000u;
    const unsigned fb = (p19 & 0x80000000u) ? (p19 ^ 0x80000000u) : ~p19;
    *cntp = n1; *taup = p19 ? __uint_as_float(fb) : -INFINITY;
  }
  LDSWAIT();
}

__device__ __forceinline__ void indexer_unit(LAS unsigned char* lds, int u, const bf16_t* H, const float* IW, unsigned short* SEL, int* NSEL) {
  const int tid = threadIdx.x, lane = tid & 63, wid = __builtin_amdgcn_readfirstlane(tid >> 6), r = lane & 31, h = lane >> 5;
  const int b = u & 1, qblk = 255 - (u >> 1);
  LAS unsigned* lists = (LAS unsigned*)lds;
  LAS float* scr = (LAS float*)(lds + L_SCR + wid * 4608);
  LAS unsigned* hist = (LAS unsigned*)(lds + L_HIST + wid * 1024);
  LAS unsigned* cnt = (LAS unsigned*)(lds + L_CNT);
  LAS float* tau = (LAS float*)(lds + L_TAU);
  LAS float* wl = (LAS float*)(lds + L_WL);
  const int q0 = qblk * 32; const size_t rowbase = (size_t)b * SEQ;
  if (tid < 32) { cnt[tid] = 0u; tau[tid] = -INFINITY; *(LAS f32x4*)(wl + tid * 4) = *(const f32x4*)(IW + (rowbase + q0 + tid) * 4); }
  bf16x8 Aq[4][4];
#pragma unroll
  for (int rt = 0; rt < 4; ++rt)
#pragma unroll
    for (int ks = 0; ks < 4; ++ks) Aq[rt][ks] = ldg16(H + (rowbase + q0 + 8 * rt + (r >> 2)) * HP + C_IQ + (r & 3) * 64 + 16 * ks + 8 * h);
  __syncthreads();
  const int nch = (q0 + 32 + 255) >> 8;
  float mytau = -INFINITY; const int myq = lane & 31, mykh = lane >> 5;
  bf16x8 Bk[4];
#pragma unroll
  for (int ks = 0; ks < 4; ++ks) Bk[ks] = ldg16(H + (rowbase + wid * 32 + r) * HP + C_IK + 16 * ks + 8 * h);
  for (int c = 0; c < nch; ++c) {
    const int kt0 = c * 256 + wid * 32;
    bf16x8 Bn[4];
#pragma unroll
    for (int ks = 0; ks < 4; ++ks) Bn[ks] = Bk[ks];
    if (c + 1 < nch) {
#pragma unroll
      for (int ks = 0; ks < 4; ++ks) Bn[ks] = ldg16(H + (rowbase + kt0 + 256 + r) * HP + C_IK + 16 * ks + 8 * h);
    }
    if (kt0 <= q0 + 31) {
#pragma unroll
      for (int rt = 0; rt < 4; ++rt) {
        f32x16 acc;
#pragma unroll
        for (int i = 0; i < 16; ++i) acc[i] = 0.f;
#pragma unroll
        for (int ks = 0; ks < 4; ++ks) acc = MFMA32(Aq[rt][ks], Bk[ks], acc);
#pragma unroll
        for (int g = 0; g < 4; ++g) {
          const int ql = 8 * rt + 2 * g + h;
          const f32x4 w = *(LAS f32x4*)(wl + ql * 4);
          float s = w[0] * relu1(acc[4 * g]);
          s = __builtin_fmaf(w[1], relu1(acc[4 * g + 1]), s); s = __builtin_fmaf(w[2], relu1(acc[4 * g + 2]), s); s = __builtin_fmaf(w[3], relu1(acc[4 * g + 3]), s);
          scr[ql * 36 + r] = s;
        }
      }
      LDSWAIT();
      f32x4 e[4];
#pragma unroll
      for (int i = 0; i < 4; ++i) e[i] = *(LAS f32x4*)(scr + myq * 36 + mykh * 16 + 4 * i);
      unsigned m = 0u;
#pragma unroll
      for (int i = 0; i < 4; ++i)
#pragma unroll
        for (int j = 0; j < 4; ++j) asm volatile("v_cmp_ge_f32 vcc, %1, %2\n\tv_addc_co_u32 %0, vcc, %0, %0, vcc" : "+v"(m) : "v"(e[i][j]), "v"(mytau) : "vcc");
      int nv = q0 + myq - (kt0 + 16 * mykh) + 1; nv = nv < 0 ? 0 : (nv > 16 ? 16 : nv);
      m &= (0xffffu << (16 - nv)) & 0xffffu;
      const unsigned np = (unsigned)__popc(m);
      unsigned pos = 0u;
      if (np) pos = __hip_atomic_fetch_add(cnt + myq, np, __ATOMIC_RELAXED, __HIP_MEMORY_SCOPE_WORKGROUP);
      LAS unsigned* lp = lists + myq * LC;
      while (m) {
        const int bb = 31 - __clz((int)m); m ^= 1u << bb;
        const int j = 15 - bb;
        const float sv = scr[myq * 36 + mykh * 16 + j];
        unsigned ub = __float_as_uint(sv); ub = (ub & 0x7fffffffu) ? ub : 0u;
        const unsigned ord = ub ^ ((unsigned)((int)ub >> 31) | 0x80000000u);
        lp[pos] = (ord & 0xffffe000u) | (unsigned)(8191 - (kt0 + 16 * mykh + j)); ++pos;
      }
    }
    __syncthreads();
    const bool last = (c == nch - 1);
    for (int qq = wid; qq < 32; qq += 8) {
      const unsigned n = cnt[qq];
      if (last ? (n > 256u) : (n > (unsigned)(LC - 256))) select_compact(lists + qq * LC, n, hist, last ? 256u : 384u, cnt + qq, tau + qq, lane);
    }
    __syncthreads();
    mytau = tau[myq];
#pragma unroll
    for (int ks = 0; ks < 4; ++ks) Bk[ks] = Bn[ks];
  }
  for (int qq = wid; qq < 32; qq += 8) {
    const unsigned n = cnt[qq]; const size_t row = rowbase + q0 + qq;
#pragma unroll
    for (int i = 0; i < 4; ++i) { const int sl = lane + 64 * i; SEL[row * 256 + sl] = (unsigned)sl < n ? (unsigned short)(8191u - (lists[qq * LC + sl] & 0x1fffu)) : (unsigned short)0; }
    if (lane == 0) NSEL[row] = (int)n;
  }
  __syncthreads();
}

__device__ __forceinline__ void sparse_attn_phase(LAS unsigned char* lds, const bf16_t* H, const unsigned short* SEL, const int* NSEL, bf16_t* MIX) {
  const int tid = threadIdx.x, lane = tid & 63, wid = __builtin_amdgcn_readfirstlane(tid >> 6), r = lane & 31, h = lane >> 5;
  const int gw = blockIdx.x * NWAVES + wid, NGW = gridDim.x * NWAVES;
  LAS unsigned char* vbuf = lds + wid * 8192;
  LAS unsigned char* selb = lds + 65536 + wid * 512;
  const int i16 = lane & 15, q4 = i16 >> 2, p4 = i16 & 3, g16 = (lane >> 4) & 1;
  const unsigned troff = (4 * h + q4) * 128 + (16 * g16 + 4 * p4) * 2;
  const bf16_t* Hk = H + C_BK + 8 * h;
  const bf16_t* Hv = H + C_BV + (lane & 7) * 8;
#define SP_LOAD(A, V, tl) do { \
    const int kidx_ = (int)*(LAS unsigned short*)(selb + 2 * (32 * (tl) + r)); \
    _Pragma("unroll") for (int ks = 0; ks < 4; ++ks) A[ks] = ldg16(Hk + (rowbase + kidx_) * HP + 16 * ks); \
    _Pragma("unroll") for (int i = 0; i < 4; ++i) { const int kiv_ = (int)*(LAS unsigned short*)(selb + 2 * (32 * (tl) + (lane >> 3) + 8 * i)); \
      V[i] = *(const u32x4*)(Hv + (rowbase + kiv_) * HP); } } while (0)
#define SP_COMPUTE(A, V, tl) do { \
    LAS unsigned char* vb = vbuf + ((tl) & 1) * 4096; \
    f32x16 S; \
    _Pragma("unroll") for (int i = 0; i < 16; ++i) S[i] = 0.f; \
    _Pragma("unroll") for (int ks = 0; ks < 4; ++ks) S = MFMA32(A[ks], Bq[ks], S); \
    _Pragma("unroll") for (int i = 0; i < 4; ++i) *(LAS u32x4*)(vb + ((lane >> 3) + 8 * i) * 128 + (lane & 7) * 16) = V[i]; \
    float tm = -INFINITY; \
    _Pragma("unroll") for (int i = 0; i < 16; ++i) { const bool valid = 32 * (tl) + crow(i, h) < n; S[i] = valid ? S[i] : -INFINITY; tm = fmaxf(tm, S[i]); } \
    tm = fmaxf(tm, __shfl_xor(tm, 32)); \
    const float mn = fmaxf(mx, tm), corr = exp2f(mx - mn); \
    mx = mn; \
    float ps = 0.f; \
    _Pragma("unroll") for (int i = 0; i < 16; ++i) { const float p = exp2f(S[i] - mn); S[i] = p; ps += p; } \
    sum = sum * corr + ps; \
    _Pragma("unroll") for (int dt = 0; dt < 2; ++dt) _Pragma("unroll") for (int i = 0; i < 16; ++i) O[dt][i] *= corr; \
    LDSWAIT(); \
    _Pragma("unroll") for (int s = 0; s < 2; ++s) { \
      const bf16x8 P = pack8(S, s); \
      _Pragma("unroll") for (int dt = 0; dt < 2; ++dt) { \
        LAS unsigned char* p = vb + troff + (16 * s) * 128 + dt * 64; \
        const s16x4 lo = tr_read(p), hi = tr_read(p + 8 * 128); \
        const bf16x8 A2 = __builtin_shufflevector(lo, hi, 0, 1, 2, 3, 4, 5, 6, 7); \
        O[dt] = MFMA32(A2, P, O[dt]); } } } while (0)
  for (int row = gw; row < M; row += NGW) {
    const size_t rowbase = (size_t)(row >> 13) * SEQ;
    const int n = __builtin_amdgcn_readfirstlane(NSEL[row]);
    const int nt = (n + 31) >> 5;
    *(LAS u32x2*)(selb + lane * 8) = *(const u32x2*)(SEL + (size_t)row * 256 + lane * 4);
    bf16x8 Bq[4];
#pragma unroll
    for (int ks = 0; ks < 4; ++ks) { bf16x8 v = ldg16(H + (size_t)row * HP + C_BQ + (r & 7) * 64 + 16 * ks + 8 * h); if (r >= 8) v = (bf16x8){0, 0, 0, 0, 0, 0, 0, 0}; Bq[ks] = v; }
    f32x16 O[2];
#pragma unroll
    for (int dt = 0; dt < 2; ++dt)
#pragma unroll
      for (int i = 0; i < 16; ++i) O[dt][i] = 0.f;
    float mx = -INFINITY, sum = 0.f;
    LDSWAIT();
    bf16x8 A0[4], A1[4]; u32x4 V0[4], V1[4];
    SP_LOAD(A0, V0, 0);
    for (int tl = 0; tl < nt; tl += 2) {
      if (tl + 1 < nt) SP_LOAD(A1, V1, tl + 1);
      SP_COMPUTE(A0, V0, tl);
      if (tl + 1 < nt) {
        if (tl + 2 < nt) SP_LOAD(A0, V0, tl + 2);
        SP_COMPUTE(A1, V1, tl + 1);
      }
    }
    sum += __shfl_xor(sum, 32);
    const float rs = 1.0f / sum;
    if (r < 8) {
#pragma unroll
      for (int dt = 0; dt < 2; ++dt)
#pragma unroll
        for (int g4 = 0; g4 < 4; ++g4) {
          const int d = 32 * dt + 8 * g4 + 4 * h;
          const u32x2 gt = *(const u32x2*)(H + (size_t)row * HP + C_BG + r * 64 + d);
          const float o0 = O[dt][4 * g4 + 0] * rs * __uint_as_float(gt.x << 16), o1 = O[dt][4 * g4 + 1] * rs * __uint_as_float(gt.x & 0xffff0000u);
          const float o2 = O[dt][4 * g4 + 2] * rs * __uint_as_float(gt.y << 16), o3 = O[dt][4 * g4 + 3] * rs * __uint_as_float(gt.y & 0xffff0000u);
          u32x2 w; w.x = cvt_pk_bf16(o0, o1); w.y = cvt_pk_bf16(o2, o3);
          *(u32x2*)(MIX + (size_t)row * DM + 512 + r * 64 + d) = w;
        }
    }
    LDSWAIT();
  }
#undef SP_LOAD
#undef SP_COMPUTE
}

__device__ __forceinline__ float wave_sum(float v) {
#pragma unroll
  for (int o = 1; o < 64; o <<= 1) v += __shfl_xor(v, o);
  return v;
}
__device__ __forceinline__ void ln_phase(const float* Y, const float* g, const float* bta, float* out) {
  const int tid = threadIdx.x, lane = tid & 63, wid = tid >> 6;
  const int gw = blockIdx.x * NWAVES + wid, NGW = gridDim.x * NWAVES;
  f32x4 gv[4], bv[4];
#pragma unroll
  for (int j = 0; j < 4; ++j) { gv[j] = *(const f32x4*)(g + 4 * lane + 256 * j); bv[j] = *(const f32x4*)(bta + 4 * lane + 256 * j); }
  for (int row = gw; row < M; row += NGW) {
    const f32x4* yr = (const f32x4*)(Y + (size_t)row * DM) + lane;
    f32x4 v[4]; float s = 0.f;
#pragma unroll
    for (int j = 0; j < 4; ++j) { v[j] = yr[64 * j]; s += (v[j][0] + v[j][1]) + (v[j][2] + v[j][3]); }
    const float mean = wave_sum(s) * (1.f / DM); float s2 = 0.f;
#pragma unroll
    for (int j = 0; j < 4; ++j) { v[j] = v[j] - mean; s2 += (v[j][0] * v[j][0] + v[j][1] * v[j][1]) + (v[j][2] * v[j][2] + v[j][3] * v[j][3]); }
    const float rstd = 1.f / sqrtf(wave_sum(s2) * (1.f / DM) + LN_EPS);
    f32x4* o = (f32x4*)(out + (size_t)row * DM) + lane;
#pragma unroll
    for (int j = 0; j < 4; ++j) o[64 * j] = v[j] * rstd * gv[j] + bv[j];
  }
}

#define XB_TMO      128
#define XB_XCNT(j)  (256  + 64 * (j))
#define XB_XSUB(j)  (1280 + 64 * (j))
#define XB_XGEN(j)  (2304 + 64 * (j))
#define XB_TOP      3328
#define XB_TOPGEN   3392
#define XCD_BAR_WORDS 3456
#define XB_SPIN_CAP (1u << 18)

__device__ __forceinline__ unsigned xb_ld(unsigned* p)              { return __hip_atomic_load(p, __ATOMIC_RELAXED, __HIP_MEMORY_SCOPE_AGENT); }
__device__ __forceinline__ unsigned xb_add(unsigned* p, unsigned v) { return __hip_atomic_fetch_add(p, v, __ATOMIC_RELAXED, __HIP_MEMORY_SCOPE_AGENT); }
__device__ __forceinline__ unsigned xb_xcc_id() { return (unsigned)__builtin_amdgcn_s_getreg((3 << 11) | 20) & 0xFu; }
#define XB_SPIN(cond, bar) do { unsigned _sp = 0; while (cond) { __builtin_amdgcn_s_sleep(1); \
    if ((++_sp & 255u) == 0u) { if (xb_ld(&(bar)[XB_TMO])) break; if (_sp > XB_SPIN_CAP) { atomicAdd(&(bar)[XB_TMO], 1u); break; } } } } while (0)

struct XcdBarrier {
    unsigned* bar; unsigned x;
    volatile LAS unsigned* st;
};

__device__ __forceinline__ XcdBarrier xcd_barrier_post(unsigned* bar, volatile LAS unsigned* st) {
    XcdBarrier b; b.bar = bar; b.x = xb_xcc_id(); b.st = st;
    if (threadIdx.x == 0) (void)xb_add(&bar[XB_XCNT(b.x)], 1u);
    return b;
}
__device__ __forceinline__ void xcd_barrier_complete(unsigned* bar, unsigned x, unsigned& nloc, unsigned& nx) {
    const unsigned G = gridDim.x * gridDim.y * gridDim.z;
    unsigned sum, cnt, mine, sp = 0u;
    for (;;) {
        sum = 0u; cnt = 0u; mine = 0u;
#pragma unroll
        for (unsigned j = 0; j < 16; ++j) { const unsigned c = xb_ld(&bar[XB_XCNT(j)]); sum += c; cnt += (c > 0u) ? 1u : 0u; mine = (j == x) ? c : mine; }
        if (sum == G) break;
        __builtin_amdgcn_s_sleep(1);
        if ((++sp & 255u) == 0u) { if (xb_ld(&bar[XB_TMO])) break; if (sp > XB_SPIN_CAP) { atomicAdd(&bar[XB_TMO], 1u); break; } }
    }
    nloc = mine > 0u ? mine : 1u; nx = cnt > 0u ? cnt : 1u;
}

__device__ __forceinline__ void xcd_barrier(const XcdBarrier& b) {
    asm volatile("s_waitcnt vmcnt(0)" ::: "memory");
    __syncthreads();
    if (threadIdx.x == 0) {
        unsigned* bar = b.bar;
        __builtin_amdgcn_s_waitcnt(0);
        unsigned nloc = b.st[0], nx = b.st[1];
        if (nloc == 0u) { xcd_barrier_complete(bar, b.x, nloc, nx); b.st[0] = nloc; b.st[1] = nx; }
        const unsigned old = xb_add(&bar[XB_XSUB(b.x)], 1u);
        const unsigned gen = old / nloc;
        if (old + 1u == (gen + 1u) * nloc) {
            __builtin_amdgcn_fence(__ATOMIC_RELEASE, "agent");
            asm volatile("s_waitcnt vmcnt(0)" ::: "memory");
            const unsigned og = xb_add(&bar[XB_TOP], 1u);
            const unsigned tg = og / nx;
            if (og + 1u == (tg + 1u) * nx) xb_add(&bar[XB_TOPGEN], 1u);
            else XB_SPIN(xb_ld(&bar[XB_TOPGEN]) == tg, bar);
            __builtin_amdgcn_fence(__ATOMIC_ACQUIRE, "agent");
            xb_add(&bar[XB_XGEN(b.x)], 1u);
            asm volatile("s_waitcnt vmcnt(0)" ::: "memory");
        } else {
            XB_SPIN(xb_ld(&bar[XB_XGEN(b.x)]) == gen, bar);
            __builtin_amdgcn_fence(__ATOMIC_ACQUIRE, "agent");
            asm volatile("s_waitcnt vmcnt(0)" ::: "memory");
        }
    }
    __syncthreads();
}

#ifndef PHMASK
#define PHMASK 255
#endif
#ifndef REPMASK
#define REPMASK 0
#endif
__global__ void __launch_bounds__(NTHREADS, 2) hybrid_fwd(Args a) {
  extern __shared__ __attribute__((aligned(16))) unsigned char lds_raw[];
  LAS unsigned char* lds = (LAS unsigned char*)lds_raw;
  cg::grid_group grid = cg::this_grid();
  const int tid = threadIdx.x;
  if (a.ws == nullptr) grid.sync();
  bf16_t* BTIN = (bf16_t*)(a.ws + WS_BTIN); bf16_t* BTOUT = (bf16_t*)(a.ws + WS_BTOUT);
  bf16_t* XN = (bf16_t*)(a.ws + WS_XN); bf16_t* H = (bf16_t*)(a.ws + WS_H); bf16_t* MIX = (bf16_t*)(a.ws + WS_MIX);
  float* IW = (float*)(a.ws + WS_IW); float* YPRE = (float*)(a.ws + WS_YPRE);
  int* NSEL = (int*)(a.ws + WS_NSEL); unsigned short* SEL = (unsigned short*)(a.ws + WS_SEL);
  unsigned* ctl = (unsigned*)(a.ws + WS_CTL);
  volatile LAS unsigned* bst = (volatile LAS unsigned*)(lds + L_BAR);
  if (tid < 2) bst[tid] = 0u;
  __syncthreads();
  const XcdBarrier bar = xcd_barrier_post(ctl + 1024, bst);
  if (PHMASK & 1) for (int rep = 0; rep < ((REPMASK & 1) ? 2 : 1); ++rep) p0_prologue(a, lds);
  xcd_barrier(bar);
  if (PHMASK & 2) {
    pg8::Gemm g{XN, BTIN, M, NPAD, DM}; pg8::StaticOrder S; S.init(M, NPAD, (int)gridDim.x, (int)blockIdx.x);
    EpiInProj E{H, IW, a.b_in, (const f32x2*)(a.ws + WS_CS)};
    pg8::gemm_phase<EpiInProj, pg8::StaticOrder, true, true>(lds, g, S, E);
  }
  if (REPMASK & 2) {
    pg8::Gemm g{XN, BTIN, M, NPAD, DM}; pg8::StaticOrder S; S.init(M, NPAD, (int)gridDim.x, (int)blockIdx.x);
    EpiInProj E{H, IW, a.b_in, (const f32x2*)(a.ws + WS_CS)};
    pg8::gemm_phase<EpiInProj, pg8::StaticOrder, true, true>(lds, g, S, E);
  }
  xcd_barrier(bar);
  if (PHMASK & 4) {
    LAS int* us = (LAS int*)(lds + L_UNIT);
    if (PHMASK & 64) for (int rep = 0; rep < ((REPMASK & 64) ? 2 : 1); ++rep) for (;;) {
      if (tid == 0) *us = (int)__hip_atomic_fetch_add(ctl + 128 * rep, 1u, __ATOMIC_RELAXED, __HIP_MEMORY_SCOPE_AGENT);
      __syncthreads();
      const int u = *us;
      __syncthreads();
      if (u >= 512) break;
      indexer_unit(lds, u, H, IW, SEL, NSEL);
    }
    if (PHMASK & 128) for (int rep = 0; rep < ((REPMASK & 128) ? 2 : 1); ++rep) for (;;) {
      if (tid == 0) *us = (int)__hip_atomic_fetch_add(ctl + 64 + 128 * rep, 1u, __ATOMIC_RELAXED, __HIP_MEMORY_SCOPE_AGENT);
      __syncthreads();
      const int u = *us;
      __syncthreads();
      if (u >= 512) break;
      swa_unit(lds, u, H, a.sinks, MIX);
    }
  }
  xcd_barrier(bar);
  if (PHMASK & 8) for (int rep = 0; rep < ((REPMASK & 8) ? 2 : 1); ++rep) sparse_attn_phase(lds, H, SEL, NSEL, MIX);
  xcd_barrier(bar);
  if (PHMASK & 16) for (int rep = 0; rep < ((REPMASK & 16) ? 2 : 1); ++rep) {
    pg8::Gemm g{MIX, BTOUT, M, DM, DM}; pg8::StaticOrder S; S.init(M, DM, (int)gridDim.x, (int)blockIdx.x);
    EpiOutProj E{YPRE, a.b_out, a.x};
    pg8::gemm_phase<EpiOutProj, pg8::StaticOrder, true, true>(lds, g, S, E);
  }
  xcd_barrier(bar);
  if (PHMASK & 32) for (int rep = 0; rep < ((REPMASK & 32) ? 2 : 1); ++rep) ln_phase(YPRE, a.ln_g, a.ln_b, a.out);
}

extern "C" void kernel_launch(void* const* d_in, const int* in_sizes, int n_in, void* d_out, int out_size, void* d_ws, size_t ws_size, hipStream_t stream) {
  static int grid = 0;
  if (grid == 0) {
    if (n_in != 9 || ws_size < WS_END) { fprintf(stderr, "kernel_launch: unexpected inputs (n_in %d, ws %zu)\n", n_in, ws_size); grid = -1; return; }
    int dev = 0, cus = 0, per_cu = 0;
    (void)hipGetDevice(&dev); (void)hipDeviceGetAttribute(&cus, hipDeviceAttributeMultiprocessorCount, dev);
    if (hipFuncSetAttribute((const void*)hybrid_fwd, hipFuncAttributeMaxDynamicSharedMemorySize, LDS_BYTES) != hipSuccess) { fprintf(stderr, "kernel_launch: hipFuncSetAttribute failed\n"); grid = -1; return; }
    (void)hipOccupancyMaxActiveBlocksPerMultiprocessor(&per_cu, (const void*)hybrid_fwd, NTHREADS, LDS_BYTES);
    if (per_cu < 1) { fprintf(stderr, "kernel_launch: occupancy query says %d blocks per CU\n", per_cu); per_cu = 1; }
    (void)hipGetLastError();
    grid = cus;
  }
  if (grid < 0) return;
  (void)hipMemsetAsync((char*)d_ws + WS_CTL, 0, 32768, stream);
  Args a{};
  a.x = (const float*)d_in[0]; a.pos = (const int*)d_in[1]; a.w_in = (const float*)d_in[2]; a.b_in = (const float*)d_in[3]; a.sinks = (const float*)d_in[4];
  a.w_out = (const float*)d_in[5]; a.b_out = (const float*)d_in[6]; a.ln_g = (const float*)d_in[7]; a.ln_b = (const float*)d_in[8];
  a.out = (float*)d_out; a.ws = (unsigned char*)d_ws;
  void* args[] = {&a};
  hipError_t e = hipLaunchCooperativeKernel((const void*)hybrid_fwd, dim3(grid), dim3(NTHREADS), args, LDS_BYTES, stream);
  if (e != hipSuccess) fprintf(stderr, "kernel_launch: cooperative launch failed: %s (grid %d)\n", hipGetErrorString(e), grid);
}
```

```cpp
#include <hip/hip_runtime.h>
#include <hip/hip_cooperative_groups.h>
#include <cstdio>
#include <cstdint>
namespace cg = cooperative_groups;
namespace pg8 {
#define PG8_LAS __attribute__((address_space(3)))
typedef unsigned short bf16_t;
typedef short bf16x8 __attribute__((ext_vector_type(8)));
typedef float f32x4 __attribute__((ext_vector_type(4)));
typedef unsigned u32x4 __attribute__((ext_vector_type(4)));
constexpr int BM = 256, BK = 64, HALF = 128, HTB = HALF * BK * 2  , STAGE_BYTES = 8 * HTB, NXCD = 8, WGM = 8;

__host__ __device__ __forceinline__ int lds_byte(int r, int c) { const int st = (r >> 4) * 2 + (c >> 5), rr = r & 15, cc = c & 31, ob = rr * 64 + cc * 2; return st * 1024 + (ob ^ (((ob >> 9) & 1) << 5)); }
__host__ __device__ __forceinline__ void stage_rc(int b, int& R, int& C) { const int st = b / 1024, sb = b % 1024, swz = sb ^ (((sb >> 9) & 1) << 5); R = (st >> 1) * 16 + swz / 64; C = (st & 1) * 32 + (swz % 64) / 2; }
__host__ __device__ __forceinline__ int perm32(int rho) { const int n = rho >> 4, i = rho & 15; return 8 * (i >> 2) + 4 * n + (i & 3); }

struct Unit { int pm, pn; };
struct Gemm { const bf16_t* A; const bf16_t* Bt; int M, N, K; };

struct StaticOrder {
    int nM, nN, nwg, G, c;
    __host__ __device__ void init(int M, int N, int G_, int c_) { nM = M / BM; nN = N / BM; nwg = nM * nN; G = G_; c = c_; }
    __host__ __device__ bool next(int i, Unit& u) const {
        const long L = (long)i * G + c; if (L >= nwg) return false;
        int wgid = (int)L; { const int q = nwg / NXCD, r = nwg % NXCD, xcd = wgid % NXCD, off = wgid / NXCD; wgid = (xcd < r ? xcd * (q + 1) : r * (q + 1) + (xcd - r) * q) + off; }
        const int nig = WGM * nN, gid = wgid / nig, fm = gid * WGM, gsz = (nM - fm) < WGM ? (nM - fm) : WGM;
        u.pm = fm + ((wgid % nig) % gsz); u.pn = (wgid % nig) / gsz; return true;
    }
    __device__ __forceinline__ void a_ready(const Unit&) const {}
    __device__ __forceinline__ void done(const Unit&) const {}
};

__device__ __forceinline__ unsigned cvt_pk_bf16(float lo, float hi) { unsigned r; asm volatile("v_cvt_pk_bf16_f32 %0, %1, %2" : "=v"(r) : "v"(lo), "v"(hi)); return r; }
template <class Epi, class Sched, bool ALIGN_EPI = false, bool SP2 = false>
__device__ __forceinline__ void gemm_phase(PG8_LAS unsigned char* lds, const Gemm g, const Sched& S, const Epi& E) {
    const int tid = threadIdx.x, wid = __builtin_amdgcn_readfirstlane(tid >> 6), lane = tid & 63, wr = wid >> 2, wc = wid & 3, fr = lane & 15, fq = lane >> 4;
    const int K = g.K, nt = K / BK;
    unsigned voffA[2], voffB[2];
#pragma unroll
    for (int i = 0; i < 2; ++i) { int R, C; stage_rc(tid * 16 + i * 8192, R, C); const int Rb = Epi::PERM ? ((R & ~31) + perm32(R & 31)) : R;
        voffA[i] = (unsigned)(R * K + C) * 2u; voffB[i] = (unsigned)(Rb * K + C) * 2u; }
    const size_t kstep = (size_t)(BK * 2);
    const size_t hstep = (size_t)HALF * K * 2;
    const size_t tstep = 2 * hstep;
    const unsigned ldsw = (unsigned)wid * 1024u;
    const int aoff = lds_byte(wr * 64 + fr, fq * 8), boff = lds_byte(wc * 32 + fr, fq * 8);
#define PG8_SA(b, h) (((b) * 2 + (h)) * HTB)
#define PG8_SB(b, h) ((4 + (b) * 2 + (h)) * HTB)
#define PG8_STAGE(bufoff, gbase, voff) do { _Pragma("unroll") for (int _i = 0; _i < 2; ++_i) \
        __builtin_amdgcn_global_load_lds((const unsigned*)((const char*)(gbase) + (voff)[_i]), (PG8_LAS unsigned*)(lds + (bufoff) + ldsw + _i * 8192), 16, 0, 0); } while (0)
#define PG8_LDA(dst, b, h) do { _Pragma("unroll") for (int m = 0; m < 4; ++m) _Pragma("unroll") for (int k = 0; k < 2; ++k) dst[m][k] = *(const PG8_LAS bf16x8*)(lds + PG8_SA(b, h) + aoff + m * 2048 + k * 1024); } while (0)
#define PG8_LDB(dst, b, h) do { _Pragma("unroll") for (int n = 0; n < 2; ++n) _Pragma("unroll") for (int k = 0; k < 2; ++k) dst[n][k] = *(const PG8_LAS bf16x8*)(lds + PG8_SB(b, h) + boff + n * 2048 + k * 1024); } while (0)
#define PG8_MMA(ai, bj, At, Bt) do { __builtin_amdgcn_s_setprio(1); _Pragma("unroll") for (int m = 0; m < 4; ++m) _Pragma("unroll") for (int n = 0; n < 2; ++n) _Pragma("unroll") for (int k = 0; k < 2; ++k) \
        acc[ai][bj][m][n] = __builtin_amdgcn_mfma_f32_16x16x32_bf16(Bt[n][k], At[m][k], acc[ai][bj][m][n], 0, 0, 0); __builtin_amdgcn_s_setprio(0); } while (0)
#define PG8_WAIT_V(n) asm volatile("s_waitcnt vmcnt(" #n ")" ::: "memory")
#define PG8_WAIT_L(n) asm volatile("s_waitcnt lgkmcnt(" #n ")" ::: "memory")
#define PG8_BAR __builtin_amdgcn_s_barrier()
#define PG8_SCHED __builtin_amdgcn_sched_barrier(0)
    Unit cur, nxt; int ui = 0;
    if (!S.next(0, cur)) return;
    f32x4 acc[2][2][4][2];
#pragma unroll
    for (int a = 0; a < 2; ++a)
#pragma unroll
        for (int b = 0; b < 2; ++b)
#pragma unroll
            for (int m = 0; m < 4; ++m)
#pragma unroll
                for (int n = 0; n < 2; ++n) acc[a][b][m][n] = (f32x4){0.f, 0.f, 0.f, 0.f};
    bf16x8 At[4][2], B0[2][2], B1[2][2];
    const char* cA = (const char*)g.A + (size_t)cur.pm * tstep; const char* cB = (const char*)g.Bt + (size_t)cur.pn * tstep;
    S.a_ready(cur);
    if constexpr (SP2) {
        PG8_STAGE(PG8_SB(0, 0), cB, voffB); PG8_STAGE(PG8_SB(0, 1), cB + hstep, voffB); PG8_STAGE(PG8_SA(0, 0), cA, voffA); PG8_STAGE(PG8_SA(0, 1), cA + hstep, voffA);
        if (wr == 1) PG8_BAR;
        PG8_WAIT_V(2); PG8_BAR;
        PG8_STAGE(PG8_SB(1, 0), cB + kstep, voffB); PG8_STAGE(PG8_SA(1, 0), cA + kstep, voffA); PG8_STAGE(PG8_SB(1, 1), cB + hstep + kstep, voffB);
        PG8_WAIT_V(6); PG8_BAR;
    } else {
        PG8_STAGE(PG8_SB(0, 0), cB, voffB); PG8_STAGE(PG8_SA(0, 0), cA, voffA); PG8_STAGE(PG8_SB(0, 1), cB + hstep, voffB); PG8_STAGE(PG8_SA(0, 1), cA + hstep, voffA);
        if (wr == 1) PG8_BAR;
        PG8_WAIT_V(4); PG8_BAR;
        PG8_STAGE(PG8_SB(1, 0), cB + kstep, voffB); PG8_STAGE(PG8_SA(1, 0), cA + kstep, voffA); PG8_STAGE(PG8_SB(1, 1), cB + hstep + kstep, voffB);
        PG8_WAIT_V(6); PG8_BAR;
    }
    for (;;) {
        const bool has_next = S.next(ui + 1, nxt);
        const char* nA = has_next ? (const char*)g.A + (size_t)nxt.pm * tstep : cA; const char* nB = has_next ? (const char*)g.Bt + (size_t)nxt.pn * tstep : cB;
        for (int t = 0; t < nt; t += 2) {
            const bool last = (t == nt - 2);
            const char* a1 = cA + (size_t)(t + 1) * kstep;
            const char* a2 = last ? nA : cA + (size_t)(t + 2) * kstep; const char* b2 = last ? nB : cB + (size_t)(t + 2) * kstep;
            const char* a3 = a2 + kstep; const char* b3 = b2 + kstep;
            if (last && has_next) S.a_ready(nxt);
            if constexpr (SP2) {
            PG8_LDB(B0, 0, 0); PG8_LDB(B1, 0, 1); PG8_SCHED; PG8_LDA(At, 0, 0); PG8_STAGE(PG8_SA(1, 1), a1 + hstep, voffA);
            PG8_WAIT_V(8); PG8_WAIT_L(0); PG8_BAR; PG8_MMA(0, 0, At, B0); PG8_MMA(0, 1, At, B1); PG8_BAR; PG8_SCHED;
            PG8_LDA(At, 0, 1); PG8_STAGE(PG8_SB(0, 0), b2, voffB); PG8_STAGE(PG8_SB(0, 1), b2 + hstep, voffB); PG8_STAGE(PG8_SA(0, 0), a2, voffA);
            PG8_WAIT_V(8); PG8_WAIT_L(0); PG8_BAR; PG8_MMA(1, 0, At, B0); PG8_MMA(1, 1, At, B1); PG8_BAR; PG8_SCHED;
            PG8_LDB(B0, 1, 0); PG8_LDB(B1, 1, 1); PG8_SCHED; PG8_LDA(At, 1, 0); PG8_STAGE(PG8_SA(0, 1), a2 + hstep, voffA);
            PG8_WAIT_V(8); PG8_WAIT_L(0); PG8_BAR; PG8_MMA(0, 0, At, B0); PG8_MMA(0, 1, At, B1); PG8_BAR; PG8_SCHED;
            PG8_LDA(At, 1, 1); PG8_STAGE(PG8_SB(1, 0), b3, voffB); PG8_STAGE(PG8_SB(1, 1), b3 + hstep, voffB); PG8_STAGE(PG8_SA(1, 0), a3, voffA);
            PG8_WAIT_V(8); PG8_WAIT_L(0); PG8_BAR; PG8_MMA(1, 0, At, B0); PG8_MMA(1, 1, At, B1); PG8_BAR; PG8_SCHED;
            } else {
            PG8_LDB(B0, 0, 0); PG8_SCHED; PG8_LDA(At, 0, 0); PG8_STAGE(PG8_SA(1, 1), a1 + hstep, voffA);
            PG8_WAIT_L(8); PG8_BAR; PG8_WAIT_L(0); PG8_MMA(0, 0, At, B0); PG8_BAR; PG8_SCHED;
            PG8_LDB(B1, 0, 1); PG8_STAGE(PG8_SB(0, 0), b2, voffB);
            PG8_BAR; PG8_WAIT_L(0); PG8_MMA(0, 1, At, B1); PG8_BAR;
            PG8_LDA(At, 0, 1); PG8_STAGE(PG8_SA(0, 0), a2, voffA);
            PG8_BAR; PG8_WAIT_L(0); PG8_MMA(1, 0, At, B0); PG8_BAR; PG8_SCHED;
            PG8_STAGE(PG8_SB(0, 1), b2 + hstep, voffB);
            PG8_WAIT_V(6); PG8_BAR; PG8_MMA(1, 1, At, B1); PG8_BAR;
            PG8_LDB(B0, 1, 0); PG8_SCHED; PG8_LDA(At, 1, 0); PG8_STAGE(PG8_SA(0, 1), a2 + hstep, voffA);
            PG8_WAIT_L(8); PG8_BAR; PG8_WAIT_L(0); PG8_MMA(0, 0, At, B0); PG8_BAR; PG8_SCHED;
            PG8_LDB(B1, 1, 1); PG8_STAGE(PG8_SB(1, 0), b3, voffB);
            PG8_BAR; PG8_WAIT_L(0); PG8_MMA(0, 1, At, B1); PG8_BAR;
            PG8_LDA(At, 1, 1); PG8_STAGE(PG8_SA(1, 0), a3, voffA);
            PG8_BAR; PG8_WAIT_L(0); PG8_MMA(1, 0, At, B0); PG8_BAR; PG8_SCHED;
            PG8_STAGE(PG8_SB(1, 1), b3 + hstep, voffB);
            PG8_WAIT_V(6); PG8_BAR; PG8_MMA(1, 1, At, B1); PG8_BAR;
            }
        }
        if constexpr (ALIGN_EPI) { if (wr == 0) PG8_BAR; }
        if constexpr (!Epi::AFTER_DRAIN) { E(acc, cur, wr, wc, fr, fq); S.done(cur); }
        if (!has_next) break;
#pragma unroll
        for (int a = 0; a < 2; ++a)
#pragma unroll
            for (int b = 0; b < 2; ++b)
#pragma unroll
                for (int m = 0; m < 4; ++m)
#pragma unroll
                    for (int n = 0; n < 2; ++n) acc[a][b][m][n] = (f32x4){0.f, 0.f, 0.f, 0.f};
        cur = nxt; cA = nA; cB = nB; ++ui;
        if constexpr (ALIGN_EPI) { if (wr == 1) PG8_BAR; }
    }
    PG8_WAIT_V(0);
    if constexpr (!ALIGN_EPI) { if (wr == 0) PG8_BAR; }
    PG8_BAR;
    if constexpr (Epi::AFTER_DRAIN) { E.fused(acc, cur, wr, wc, fr, fq, lds, wid, lane); S.done(cur); }
#undef PG8_SA
#undef PG8_SB
#undef PG8_STAGE
#undef PG8_LDA
#undef PG8_LDB
#undef PG8_MMA
#undef PG8_WAIT_V
#undef PG8_WAIT_L
#undef PG8_BAR
#undef PG8_SCHED
}
}
#define LAS __attribute__((address_space(3)))
typedef unsigned short bf16_t;
typedef short bf16x8 __attribute__((ext_vector_type(8)));
typedef short s16x4 __attribute__((ext_vector_type(4)));
typedef float f32x4 __attribute__((ext_vector_type(4)));
typedef float f32x2 __attribute__((ext_vector_type(2)));
typedef float f32x16 __attribute__((ext_vector_type(16)));
typedef unsigned u32x4 __attribute__((ext_vector_type(4)));
typedef unsigned u32x2 __attribute__((ext_vector_type(2)));
using pg8::cvt_pk_bf16;

constexpr int SEQ = 8192, NB = 2, M = NB * SEQ, DM = 1024, NCOL = 2756, NPAD = 2816, HP = 2752;
constexpr int C_AQ = 0, C_AK = 512, C_AV = 640, C_AG = 768, C_BQ = 1280, C_BK = 1792, C_BV = 1856, C_BG = 1920, C_IQ = 2432, C_IK = 2688, C_IW = 2752;
constexpr float LOG2E = 1.4426950408889634f, QSCALE = 0.125f * LOG2E, LN_EPS = 1e-5f;
constexpr float ALPHA = 1.189207115002721f;
constexpr size_t MiB = 1u << 20;
constexpr size_t WS_CTL = 0, WS_BTIN = 2 * MiB, WS_BTOUT = 8 * MiB, WS_CS = 10 * MiB, WS_IW = 14 * MiB, WS_NSEL = 15 * MiB, WS_SEL = 16 * MiB,
                 WS_XN = 24 * MiB, WS_H = 56 * MiB, WS_MIX = 142 * MiB, WS_YPRE = 174 * MiB, WS_END = 238 * MiB;
constexpr int LDS_BYTES = 160768;
constexpr int NTHREADS = 512, NWAVES = 8;
#define MFMA32(a, b, c) __builtin_amdgcn_mfma_f32_32x32x16_bf16((a), (b), (c), 0, 0, 0)
#define LDSWAIT() asm volatile("s_waitcnt lgkmcnt(0)" ::: "memory")

__device__ __forceinline__ int crow(int i, int h) { return (i & 3) + 8 * (i >> 2) + 4 * h; }
__device__ __forceinline__ int swap45(int c) { return (c & ~48) | ((c & 16) << 1) | ((c & 32) >> 1); }
__device__ __forceinline__ float bf2f(unsigned short b) { return __uint_as_float((unsigned)b << 16); }
__device__ __forceinline__ bf16x8 ldg16(const bf16_t* p) { return *(const bf16x8*)p; }
__device__ __forceinline__ bf16x8 pack8(const f32x16& x, int s) {
  u32x4 p; p.x = cvt_pk_bf16(x[8 * s + 0], x[8 * s + 1]); p.y = cvt_pk_bf16(x[8 * s + 2], x[8 * s + 3]); p.z = cvt_pk_bf16(x[8 * s + 4], x[8 * s + 5]); p.w = cvt_pk_bf16(x[8 * s + 6], x[8 * s + 7]);
  return __builtin_bit_cast(bf16x8, p);
}
__device__ __forceinline__ float relu1(float x) { return __builtin_amdgcn_fmed3f(x, 0.f, __builtin_inff()); }
__device__ __forceinline__ s16x4 tr_read(LAS unsigned char* p) { return __builtin_amdgcn_ds_read_tr16_b64_v4i16((LAS s16x4*)p); }

struct Args { const float* x; const int* pos; const float* w_in; const float* b_in; const float* sinks; const float* w_out; const float* b_out; const float* ln_g; const float* ln_b;
              float* out; unsigned char* ws; };

__device__ __forceinline__ void p0_transpose_item(const float* W, int N, bf16_t* WT, bool perm, LAS float* scr, int item, int nblk, int lane) {
  const int kb = item / nblk, nb = item % nblk, k0 = 64 * kb, n0 = 32 * nb;
  const int nn = n0 + (lane & 31);
#pragma unroll 8
  for (int i = 0; i < 32; ++i) { const int kk = 2 * i + (lane >> 5); scr[kk * 33 + (lane & 31)] = nn < N ? W[(size_t)(k0 + kk) * N + nn] : 0.f; }
  LDSWAIT();
  const int c = lane & 7;
#pragma unroll
  for (int j = 0; j < 4; ++j) { const int n = (lane >> 3) + 8 * j; const LAS float* s = scr + (8 * c) * 33 + n;
    u32x4 o; o.x = cvt_pk_bf16(s[0 * 33], s[1 * 33]); o.y = cvt_pk_bf16(s[2 * 33], s[3 * 33]); o.z = cvt_pk_bf16(s[4 * 33], s[5 * 33]); o.w = cvt_pk_bf16(s[6 * 33], s[7 * 33]);
    const int grow = perm ? swap45(n0 + n) : (n0 + n);
    *(u32x4*)(WT + (size_t)grow * 1024 + k0 + 8 * c) = o; }
  LDSWAIT();
}
__device__ __forceinline__ void p0_prologue(const Args& a, LAS unsigned char* lds) {
  const int tid = threadIdx.x, lane = tid & 63, wid = tid >> 6;
  const int gw = blockIdx.x * NWAVES + wid, NGW = gridDim.x * NWAVES;
  LAS float* scr = (LAS float*)(lds + wid * 16384);
  bf16_t* BTIN = (bf16_t*)(a.ws + WS_BTIN); bf16_t* BTOUT = (bf16_t*)(a.ws + WS_BTOUT);
  constexpr int NBI = NPAD / 32, I_IN = 16 * NBI, I_OUT = 16 * 32;
  for (int it = gw; it < I_IN + I_OUT; it += NGW) {
    if (it < I_IN) p0_transpose_item(a.w_in, NCOL, BTIN, true, scr, it, NBI, lane);
    else p0_transpose_item(a.w_out, DM, BTOUT, false, scr, it - I_IN, 32, lane);
  }
  const int gt = blockIdx.x * NTHREADS + tid, NGT = gridDim.x * NTHREADS;
  bf16_t* XN = (bf16_t*)(a.ws + WS_XN);
  for (int i = gt; i < M * DM / 8; i += NGT) {
    const f32x4 v0 = *(const f32x4*)(a.x + (size_t)i * 8), v1 = *(const f32x4*)(a.x + (size_t)i * 8 + 4);
    u32x4 o; o.x = cvt_pk_bf16(v0[0], v0[1]); o.y = cvt_pk_bf16(v0[2], v0[3]); o.z = cvt_pk_bf16(v1[0], v1[1]); o.w = cvt_pk_bf16(v1[2], v1[3]);
    *(u32x4*)(XN + (size_t)i * 8) = o;
  }
  f32x2* CS = (f32x2*)(a.ws + WS_CS);
  for (int i = gt; i < M * 32; i += NGT) {
    const int row = i >> 5, j = i & 31;
    const float inv = exp2f(-(float)j * (13.287712379549449f / 32.0f));
    const float ang = (float)a.pos[row] * inv;
    CS[i] = (f32x2){cosf(ang), sinf(ang)};
  }
}

struct EpiInProj {
  static constexpr bool PERM = false, AFTER_DRAIN = false;
  bf16_t* H; float* IW; const float* bias; const f32x2* CS;
  __device__ __forceinline__ void operator()(const f32x4 (&acc)[2][2][4][2], const pg8::Unit& u, int wr, int wc, int fr, int fq) const {
    const int row0 = u.pm * 256 + wr * 64 + fr;
    const int dloc = 16 * (wc & 1) + 4 * fq;
#pragma unroll
    for (int bj = 0; bj < 2; ++bj) {
      const int G = 4 * u.pn + 2 * bj + (wc >> 1);
      if (G >= 44) continue;
      const int col1 = 64 * G + dloc;
      if (G == 43) {
        if (dloc == 0) {
          const f32x4 b1 = *(const f32x4*)(bias + col1);
#pragma unroll
          for (int ai = 0; ai < 2; ++ai)
#pragma unroll
            for (int m = 0; m < 4; ++m) { const int row = row0 + 128 * ai + 16 * m; *(f32x4*)(IW + (size_t)row * 4) = (acc[ai][bj][m][0] + b1) * 0.0625f; }
        }
        continue;
      }
      const f32x4 b1 = *(const f32x4*)(bias + col1), b2 = *(const f32x4*)(bias + col1 + 32);
      const bool rope = (G < 10) || (G >= 20 && G < 29) || (G >= 38);
      const bool silu = (G >= 12 && G < 20) || (G >= 30 && G < 38);
      const float sc = ((G < 8) || (G >= 20 && G < 28)) ? QSCALE : 1.0f;
#pragma unroll
      for (int ai = 0; ai < 2; ++ai)
#pragma unroll
        for (int m = 0; m < 4; ++m) {
          const int row = row0 + 128 * ai + 16 * m;
          f32x4 v1 = acc[ai][bj][m][0] + b1, v2 = acc[ai][bj][m][1] + b2;
          if (rope) {
            const f32x4 cs0 = *(const f32x4*)((const float*)CS + ((size_t)row * 32 + dloc) * 2), cs1 = *(const f32x4*)((const float*)CS + ((size_t)row * 32 + dloc) * 2 + 4);
            const f32x4 c = {cs0[0], cs0[2], cs1[0], cs1[2]}, s = {cs0[1], cs0[3], cs1[1], cs1[3]};
            const f32x4 o1 = v1 * c - v2 * s, o2 = v2 * c + v1 * s;
            v1 = o1 * sc; v2 = o2 * sc;
          } else if (silu) {
#pragma unroll
            for (int i = 0; i < 4; ++i) { v1[i] = v1[i] / (1.0f + __expf(-v1[i])); v2[i] = v2[i] / (1.0f + __expf(-v2[i])); }
          }
          u32x2 w1, w2; w1.x = cvt_pk_bf16(v1[0], v1[1]); w1.y = cvt_pk_bf16(v1[2], v1[3]); w2.x = cvt_pk_bf16(v2[0], v2[1]); w2.y = cvt_pk_bf16(v2[2], v2[3]);
          bf16_t* p = H + (size_t)row * HP + col1;
          *(u32x2*)p = w1; *(u32x2*)(p + 32) = w2;
        }
    }
  }
};
struct EpiOutProj {
  static constexpr bool PERM = false, AFTER_DRAIN = false;
  float* Y; const float* bias; const float* x;
  __device__ __forceinline__ void operator()(const f32x4 (&acc)[2][2][4][2], const pg8::Unit& u, int wr, int wc, int fr, int fq) const {
    const int row0 = u.pm * 256 + wr * 64 + fr, col0 = u.pn * 256 + wc * 32 + 4 * fq;
#pragma unroll
    for (int bj = 0; bj < 2; ++bj)
#pragma unroll
      for (int n = 0; n < 2; ++n) { const int col = col0 + 128 * bj + 16 * n; const f32x4 bv = *(const f32x4*)(bias + col);
#pragma unroll
        for (int ai = 0; ai < 2; ++ai)
#pragma unroll
          for (int m = 0; m < 4; ++m) { const size_t off = (size_t)(row0 + 128 * ai + 16 * m) * DM + col;
            *(f32x4*)(Y + off) = acc[ai][bj][m][n] + bv + ALPHA * *(const f32x4*)(x + off); } }
  }
};
__device__ __forceinline__ void swa_unit(LAS unsigned char* lds, int u, const bf16_t* H, const float* sinks, bf16_t* MIX) {
  const int tid = threadIdx.x, lane = tid & 63, wid = __builtin_amdgcn_readfirstlane(tid >> 6), r = lane & 31, h = lane >> 5;
  const int g = u & 1, qb = (u >> 1) & 127, b = u >> 8;
  const size_t rowbase = (size_t)b * SEQ;
  const int t00 = qb * 64, kbase = t00 - 128;
  for (int i = tid; i < 192 * 8; i += NTHREADS) {
    const int kl = i >> 3, piece = i & 7, key = kbase + kl;
    u32x4 v = {0u, 0u, 0u, 0u};
    if (key >= 0) v = *(const u32x4*)(H + (rowbase + key) * HP + C_AV + g * 64 + piece * 8);
    *(LAS u32x4*)(lds + kl * 128 + piece * 16) = v;
  }
  __syncthreads();
  const int r4 = wid & 3, sub = wid >> 2, hq = g * 4 + r4, t0 = t00 + 32 * sub;
  bf16x8 Bq[4];
#pragma unroll
  for (int ks = 0; ks < 4; ++ks) Bq[ks] = ldg16(H + (rowbase + t0 + r) * HP + C_AQ + hq * 64 + 16 * ks + 8 * h);
  f32x16 S[5];
#pragma unroll
  for (int tl = 0; tl < 5; ++tl) {
    const int key = t0 - 128 + 32 * tl + r, kc = key < 0 ? 0 : key;
    f32x16 acc;
#pragma unroll
    for (int i = 0; i < 16; ++i) acc[i] = 0.f;
#pragma unroll
    for (int ks = 0; ks < 4; ++ks) { const bf16x8 A = ldg16(H + (rowbase + kc) * HP + C_AK + g * 64 + 16 * ks + 8 * h); acc = MFMA32(A, Bq[ks], acc); }
    S[tl] = acc;
  }
  const float sk = sinks[hq] * LOG2E;
  float mx = sk;
#pragma unroll
  for (int tl = 0; tl < 5; ++tl)
#pragma unroll
    for (int i = 0; i < 16; ++i) {
      const int rel = r + 128 - 32 * tl - crow(i, h), key = t0 + r - rel;
      const bool valid = rel >= 0 && rel < 128 && key >= 0;
      S[tl][i] = valid ? S[tl][i] : -INFINITY;
      mx = fmaxf(mx, S[tl][i]);
    }
  mx = fmaxf(mx, __shfl_xor(mx, 32));
  float sum = 0.f;
#pragma unroll
  for (int tl = 0; tl < 5; ++tl)
#pragma unroll
    for (int i = 0; i < 16; ++i) { const float p = exp2f(S[tl][i] - mx); S[tl][i] = p; sum += p; }
  sum += __shfl_xor(sum, 32);
  sum += exp2f(sk - mx);
  const float rs = 1.0f / sum;
  f32x16 O[2];
#pragma unroll
  for (int dt = 0; dt < 2; ++dt)
#pragma unroll
    for (int i = 0; i < 16; ++i) O[dt][i] = 0.f;
  const int i16 = lane & 15, q4 = i16 >> 2, p4 = i16 & 3, g16 = (lane >> 4) & 1;
  LAS unsigned char* vb = lds + (32 * sub + 4 * h + q4) * 128 + (16 * g16 + 4 * p4) * 2;
#pragma unroll
  for (int tl = 0; tl < 5; ++tl)
#pragma unroll
    for (int s = 0; s < 2; ++s) {
      const bf16x8 P = pack8(S[tl], s);
#pragma unroll
      for (int dt = 0; dt < 2; ++dt) {
        LAS unsigned char* p = vb + (32 * tl + 16 * s) * 128 + dt * 64;
        const s16x4 lo = tr_read(p), hi = tr_read(p + 8 * 128);
        const bf16x8 A2 = __builtin_shufflevector(lo, hi, 0, 1, 2, 3, 4, 5, 6, 7);
        O[dt] = MFMA32(A2, P, O[dt]);
      }
    }
  const size_t row = rowbase + t0 + r;
#pragma unroll
  for (int dt = 0; dt < 2; ++dt)
#pragma unroll
    for (int g4 = 0; g4 < 4; ++g4) {
      const int d = 32 * dt + 8 * g4 + 4 * h;
      const u32x2 gt = *(const u32x2*)(H + row * HP + C_AG + hq * 64 + d);
      const float o0 = O[dt][4 * g4 + 0] * rs * __uint_as_float(gt.x << 16), o1 = O[dt][4 * g4 + 1] * rs * __uint_as_float(gt.x & 0xffff0000u);
      const float o2 = O[dt][4 * g4 + 2] * rs * __uint_as_float(gt.y << 16), o3 = O[dt][4 * g4 + 3] * rs * __uint_as_float(gt.y & 0xffff0000u);
      u32x2 w; w.x = cvt_pk_bf16(o0, o1); w.y = cvt_pk_bf16(o2, o3);
      *(u32x2*)(MIX + row * DM + hq * 64 + d) = w;
    }
  __syncthreads();
}

constexpr int LC = 960, L_SCR = 32 * LC * 4, L_CNT = L_SCR + 8 * 4608, L_TAU = L_CNT + 128, L_WL = L_TAU + 128, L_UNIT = L_WL + 512, L_BAR = L_UNIT + 64;
static_assert(L_BAR + 64 <= LDS_BYTES, "LDS map");
__device__ __forceinline__ void radix_pass2(LAS unsigned* L, unsigned n, LAS unsigned* hist, int shift_hi, unsigned& prefix, unsigned& mask, unsigned& kk, unsigned& kept, int lane) {
#pragma unroll 1
  for (int p = 0; p < 2; ++p) {
    const int shift = shift_hi - 8 * p;
    *(LAS u32x4*)(hist + 4 * lane) = (u32x4){0u, 0u, 0u, 0u};
    LDSWAIT();
    for (unsigned i = 4u * lane; i < n; i += 256u) {
      const u32x4 e4 = *(LAS u32x4*)(L + i);
#pragma unroll
      for (int j = 0; j < 4; ++j) { const unsigned e = e4[j]; if (i + j < n && (e & mask) == prefix) __hip_atomic_fetch_add(hist + ((e >> shift) & 255u), 1u, __ATOMIC_RELAXED, __HIP_MEMORY_SCOPE_WORKGROUP); }
    }
    LDSWAIT();
    const u32x4 hb = *(LAS u32x4*)(hist + 4 * lane);
    const unsigned s4 = hb.x + hb.y + hb.z + hb.w;
    unsigned incl = s4;
#pragma unroll
    for (int o = 1; o < 64; o <<= 1) { const unsigned t = __shfl_down(incl, o); if (lane + o < 64) incl += t; }
    unsigned run = incl - s4;
    bool found = false; unsigned Bl = 0u, abl = 0u, bcl = 0u;
#pragma unroll
    for (int bb = 3; bb >= 0; --bb) { const unsigned c = hb[bb]; if (!found && run < kk && run + c >= kk) { found = true; Bl = 4u * lane + bb; abl = run; bcl = c; } run += c; }
    const unsigned long long fm = __ballot(found);
    const int src = __ffsll((long long)fm) - 1;
    const unsigned B = (unsigned)__builtin_amdgcn_readlane((int)Bl, src), above = (unsigned)__builtin_amdgcn_readlane((int)abl, src), bc = (unsigned)__builtin_amdgcn_readlane((int)bcl, src);
    prefix |= B << shift; mask |= 255u << shift;
    kept = (256u - kk) + above + bc;
    kk -= above;
  }
}
__device__ __forceinline__ unsigned compact_ge(LAS unsigned* L, unsigned n, unsigned prefix, int lane) {
  unsigned off = 0u;
  for (unsigned base = 0; base < n; base += 64) {
    const unsigned i = base + lane; const unsigned e = (i < n) ? L[i] : 0u; const bool keep = (i < n) && (e >= prefix);
    const unsigned long long km = __ballot(keep);
    const unsigned pos = off + (unsigned)__popcll(km & ((1ull << lane) - 1ull));
    if (keep) L[pos] = e;
    off += (unsigned)__popcll(km);
  }
  LDSWAIT();
  return off;
}
__device__ __forceinline__ void select_compact(LAS unsigned* L, unsigned n, LAS unsigned* hist, unsigned limit, LAS unsigned* cntp, LAS float* taup, int lane) {
  unsigned prefix = 0u, mask = 0u, kk = 256u, kept = n;
  radix_pass2(L, n, hist, 24, prefix, mask, kk, kept, lane);
  unsigned n1 = compact_ge(L, n, prefix, lane);
  if (n1 > limit) {
    radix_pass2(L, n1, hist, 8, prefix, mask, kk, kept, lane);
    n1 = compact_ge(L, n1, prefix, lane);
  }
  if (lane == 0) {
    const unsigned p19 = prefix & 0xffffe000u;
    const unsigned fb = (p19 & 0x80000000u) ? (p19 ^ 0x80000000u) : ~p19;
    *cntp = n1; *taup = p19 ? __uint_as_float(fb) : -INFINITY;
  }
  LDSWAIT();
}

__device__ __forceinline__ void indexer_unit(LAS unsigned char* lds, int u, const bf16_t* H, const float* IW, unsigned short* SEL, int* NSEL) {
  const int tid = threadIdx.x, lane = tid & 63, wid = __builtin_amdgcn_readfirstlane(tid >> 6), r = lane & 31, h = lane >> 5;
  const int b = u & 1, qblk = 255 - (u >> 1);
  LAS unsigned* lists = (LAS unsigned*)lds;
  LAS float* scr = (LAS float*)(lds + L_SCR + wid * 4608);
  LAS unsigned* hist = (LAS unsigned*)(lds + L_SCR + wid * 4608);
  LAS unsigned* cnt = (LAS unsigned*)(lds + L_CNT);
  LAS float* tau = (LAS float*)(lds + L_TAU);
  LAS float* wl = (LAS float*)(lds + L_WL);
  const int q0 = qblk * 32; const size_t rowbase = (size_t)b * SEQ;
  if (tid < 32) { cnt[tid] = 0u; tau[tid] = -INFINITY; *(LAS f32x4*)(wl + tid * 4) = *(const f32x4*)(IW + (rowbase + q0 + tid) * 4); }
  bf16x8 Aq[4][4];
#pragma unroll
  for (int rt = 0; rt < 4; ++rt)
#pragma unroll
    for (int ks = 0; ks < 4; ++ks) Aq[rt][ks] = ldg16(H + (rowbase + q0 + 8 * rt + (r >> 2)) * HP + C_IQ + (r & 3) * 64 + 16 * ks + 8 * h);
  __syncthreads();
  const int nch = (q0 + 32 + 255) >> 8;
  float mytau = -INFINITY; const int myq = lane & 31, mykh = lane >> 5;
  bf16x8 Bk[4];
#pragma unroll
  for (int ks = 0; ks < 4; ++ks) Bk[ks] = ldg16(H + (rowbase + wid * 32 + r) * HP + C_IK + 16 * ks + 8 * h);
#define IDX_SCORE(c_) do { const int kt0_ = (c_) * 256 + wid * 32; \
    if (kt0_ <= q0 + 31) { \
      _Pragma("unroll") for (int rt = 0; rt < 4; ++rt) { \
        f32x16 acc; \
        _Pragma("unroll") for (int i = 0; i < 16; ++i) acc[i] = 0.f; \
        _Pragma("unroll") for (int ks = 0; ks < 4; ++ks) acc = MFMA32(Aq[rt][ks], Bk[ks], acc); \
        _Pragma("unroll") for (int g = 0; g < 4; ++g) { \
          const int ql = 8 * rt + 2 * g + h; \
          const f32x4 w = *(LAS f32x4*)(wl + ql * 4); \
          float s = w[0] * relu1(acc[4 * g]); \
          s = __builtin_fmaf(w[1], relu1(acc[4 * g + 1]), s); s = __builtin_fmaf(w[2], relu1(acc[4 * g + 2]), s); s = __builtin_fmaf(w[3], relu1(acc[4 * g + 3]), s); \
          scr[ql * 36 + r] = s; } } } } while (0)
  IDX_SCORE(0);
  for (int c = 0; c < nch; ++c) {
    const int kt0 = c * 256 + wid * 32;
    if (c + 1 < nch) {
#pragma unroll
      for (int ks = 0; ks < 4; ++ks) Bk[ks] = ldg16(H + (rowbase + kt0 + 256 + r) * HP + C_IK + 16 * ks + 8 * h);
    }
    if (kt0 <= q0 + 31) {
      LDSWAIT();
      f32x4 e[4];
#pragma unroll
      for (int i = 0; i < 4; ++i) e[i] = *(LAS f32x4*)(scr + myq * 36 + mykh * 16 + 4 * i);
      unsigned m = 0u;
#pragma unroll
      for (int i = 0; i < 4; ++i)
#pragma unroll
        for (int j = 0; j < 4; ++j) asm volatile("v_cmp_ge_f32 vcc, %1, %2\n\tv_addc_co_u32 %0, vcc, %0, %0, vcc" : "+v"(m) : "v"(e[i][j]), "v"(mytau) : "vcc");
      int nv = q0 + myq - (kt0 + 16 * mykh) + 1; nv = nv < 0 ? 0 : (nv > 16 ? 16 : nv);
      m &= (0xffffu << (16 - nv)) & 0xffffu;
      const unsigned np = (unsigned)__popc(m);
      unsigned pos = 0u;
      if (np) pos = __hip_atomic_fetch_add(cnt + myq, np, __ATOMIC_RELAXED, __HIP_MEMORY_SCOPE_WORKGROUP);
      LAS unsigned* lp = lists + myq * LC;
      while (m) {
        const int bb = 31 - __clz((int)m); m ^= 1u << bb;
        const int j = 15 - bb;
        const float sv = scr[myq * 36 + mykh * 16 + j];
        unsigned ub = __float_as_uint(sv); ub = (ub & 0x7fffffffu) ? ub : 0u;
        const unsigned ord = ub ^ ((unsigned)((int)ub >> 31) | 0x80000000u);
        lp[pos] = (ord & 0xffffe000u) | (unsigned)(8191 - (kt0 + 16 * mykh + j)); ++pos;
      }
    }
    __syncthreads();
    const bool last = (c == nch - 1);
    for (int qq = wid; qq < 32; qq += 8) {
      const unsigned n = cnt[qq];
      if (last ? (n > 256u) : (n > (unsigned)(LC - 256))) select_compact(lists + qq * LC, n, hist, last ? 256u : 384u, cnt + qq, tau + qq, lane);
    }
    if (!last) IDX_SCORE(c + 1);
    __syncthreads();
    mytau = tau[myq];
  }
#undef IDX_SCORE
  for (int qq = wid; qq < 32; qq += 8) {
    const unsigned n = cnt[qq]; const size_t row = rowbase + q0 + qq;
#pragma unroll
    for (int i = 0; i < 4; ++i) { const int sl = lane + 64 * i; SEL[row * 256 + sl] = (unsigned)sl < n ? (unsigned short)(8191u - (lists[qq * LC + sl] & 0x1fffu)) : (unsigned short)0; }
    if (lane == 0) NSEL[row] = (int)n;
  }
  __syncthreads();
}

__device__ __forceinline__ void sparse_attn_phase(LAS unsigned char* lds, const bf16_t* H, const unsigned short* SEL, const int* NSEL, bf16_t* MIX) {
  const int tid = threadIdx.x, lane = tid & 63, wid = __builtin_amdgcn_readfirstlane(tid >> 6), r = lane & 31, h = lane >> 5;
  const int gw = blockIdx.x * NWAVES + wid, NGW = gridDim.x * NWAVES;
  LAS unsigned char* vbuf = lds + wid * 8192;
  LAS unsigned char* selb = lds + 65536 + wid * 512;
  const int i16 = lane & 15, q4 = i16 >> 2, p4 = i16 & 3, g16 = (lane >> 4) & 1;
  const unsigned troff = (4 * h + q4) * 128 + (16 * g16 + 4 * p4) * 2;
  const bf16_t* Hk = H + C_BK + 8 * h;
  const bf16_t* Hv = H + C_BV + (lane & 7) * 8;
#define SP_LOAD(A, V, tl) do { \
    const int kidx_ = (int)*(LAS unsigned short*)(selb + 2 * (32 * (tl) + r)); \
    _Pragma("unroll") for (int ks = 0; ks < 4; ++ks) A[ks] = ldg16(Hk + (rowbase + kidx_) * HP + 16 * ks); \
    _Pragma("unroll") for (int i = 0; i < 4; ++i) { const int kiv_ = (int)*(LAS unsigned short*)(selb + 2 * (32 * (tl) + (lane >> 3) + 8 * i)); \
      V[i] = *(const u32x4*)(Hv + (rowbase + kiv_) * HP); } } while (0)
#define SP_COMPUTE(A, V, tl) do { \
    LAS unsigned char* vb = vbuf + ((tl) & 1) * 4096; \
    f32x16 S; \
    _Pragma("unroll") for (int i = 0; i < 16; ++i) S[i] = 0.f; \
    _Pragma("unroll") for (int ks = 0; ks < 4; ++ks) S = MFMA32(A[ks], Bq[ks], S); \
    _Pragma("unroll") for (int i = 0; i < 4; ++i) *(LAS u32x4*)(vb + ((lane >> 3) + 8 * i) * 128 + (lane & 7) * 16) = V[i]; \
    float tm = -INFINITY; \
    _Pragma("unroll") for (int i = 0; i < 16; ++i) { const bool valid = 32 * (tl) + crow(i, h) < n; S[i] = valid ? S[i] : -INFINITY; tm = fmaxf(tm, S[i]); } \
    tm = fmaxf(tm, __shfl_xor(tm, 32)); \
    const float mn = fmaxf(mx, tm), corr = exp2f(mx - mn); \
    mx = mn; \
    float ps = 0.f; \
    _Pragma("unroll") for (int i = 0; i < 16; ++i) { const float p = exp2f(S[i] - mn); S[i] = p; ps += p; } \
    sum = sum * corr + ps; \
    _Pragma("unroll") for (int dt = 0; dt < 2; ++dt) _Pragma("unroll") for (int i = 0; i < 16; ++i) O[dt][i] *= corr; \
    LDSWAIT(); \
    _Pragma("unroll") for (int s = 0; s < 2; ++s) { \
      const bf16x8 P = pack8(S, s); \
      _Pragma("unroll") for (int dt = 0; dt < 2; ++dt) { \
        LAS unsigned char* p = vb + troff + (16 * s) * 128 + dt * 64; \
        const s16x4 lo = tr_read(p), hi = tr_read(p + 8 * 128); \
        const bf16x8 A2 = __builtin_shufflevector(lo, hi, 0, 1, 2, 3, 4, 5, 6, 7); \
        O[dt] = MFMA32(A2, P, O[dt]); } } } while (0)
  for (int row = gw; row < M; row += NGW) {
    const size_t rowbase = (size_t)(row >> 13) * SEQ;
    const int n = __builtin_amdgcn_readfirstlane(NSEL[row]);
    const int nt = (n + 31) >> 5;
    *(LAS u32x2*)(selb + lane * 8) = *(const u32x2*)(SEL + (size_t)row * 256 + lane * 4);
    bf16x8 Bq[4];
#pragma unroll
    for (int ks = 0; ks < 4; ++ks) { bf16x8 v = ldg16(H + (size_t)row * HP + C_BQ + (r & 7) * 64 + 16 * ks + 8 * h); if (r >= 8) v = (bf16x8){0, 0, 0, 0, 0, 0, 0, 0}; Bq[ks] = v; }
    f32x16 O[2];
#pragma unroll
    for (int dt = 0; dt < 2; ++dt)
#pragma unroll
      for (int i = 0; i < 16; ++i) O[dt][i] = 0.f;
    float mx = -INFINITY, sum = 0.f;
    LDSWAIT();
    bf16x8 A0[4], A1[4]; u32x4 V0[4], V1[4];
    SP_LOAD(A0, V0, 0);
    for (int tl = 0; tl < nt; tl += 2) {
      if (tl + 1 < nt) SP_LOAD(A1, V1, tl + 1);
      SP_COMPUTE(A0, V0, tl);
      if (tl + 1 < nt) {
        if (tl + 2 < nt) SP_LOAD(A0, V0, tl + 2);
        SP_COMPUTE(A1, V1, tl + 1);
      }
    }
    sum += __shfl_xor(sum, 32);
    const float rs = 1.0f / sum;
    if (r < 8) {
#pragma unroll
      for (int dt = 0; dt < 2; ++dt)
#pragma unroll
        for (int g4 = 0; g4 < 4; ++g4) {
          const int d = 32 * dt + 8 * g4 + 4 * h;
          const u32x2 gt = *(const u32x2*)(H + (size_t)row * HP + C_BG + r * 64 + d);
          const float o0 = O[dt][4 * g4 + 0] * rs * __uint_as_float(gt.x << 16), o1 = O[dt][4 * g4 + 1] * rs * __uint_as_float(gt.x & 0xffff0000u);
          const float o2 = O[dt][4 * g4 + 2] * rs * __uint_as_float(gt.y << 16), o3 = O[dt][4 * g4 + 3] * rs * __uint_as_float(gt.y & 0xffff0000u);
          u32x2 w; w.x = cvt_pk_bf16(o0, o1); w.y = cvt_pk_bf16(o2, o3);
          *(u32x2*)(MIX + (size_t)row * DM + 512 + r * 64 + d) = w;
        }
    }
    LDSWAIT();
  }
#undef SP_LOAD
#undef SP_COMPUTE
}

__device__ __forceinline__ float wave_sum(float v) {
#pragma unroll
  for (int o = 1; o < 64; o <<= 1) v += __shfl_xor(v, o);
  return v;
}
__device__ __forceinline__ void ln_phase(const float* Y, const float* g, const float* bta, float* out) {
  const int tid = threadIdx.x, lane = tid & 63, wid = tid >> 6;
  const int gw = blockIdx.x * NWAVES + wid, NGW = gridDim.x * NWAVES;
  f32x4 gv[4], bv[4];
#pragma unroll
  for (int j = 0; j < 4; ++j) { gv[j] = *(const f32x4*)(g + 4 * lane + 256 * j); bv[j] = *(const f32x4*)(bta + 4 * lane + 256 * j); }
  for (int row = gw; row < M; row += NGW) {
    const f32x4* yr = (const f32x4*)(Y + (size_t)row * DM) + lane;
    f32x4 v[4]; float s = 0.f;
#pragma unroll
    for (int j = 0; j < 4; ++j) { v[j] = yr[64 * j]; s += (v[j][0] + v[j][1]) + (v[j][2] + v[j][3]); }
    const float mean = wave_sum(s) * (1.f / DM); float s2 = 0.f;
#pragma unroll
    for (int j = 0; j < 4; ++j) { v[j] = v[j] - mean; s2 += (v[j][0] * v[j][0] + v[j][1] * v[j][1]) + (v[j][2] * v[j][2] + v[j][3] * v[j][3]); }
    const float rstd = 1.f / sqrtf(wave_sum(s2) * (1.f / DM) + LN_EPS);
    f32x4* o = (f32x4*)(out + (size_t)row * DM) + lane;
#pragma unroll
    for (int j = 0; j < 4; ++j) o[64 * j] = v[j] * rstd * gv[j] + bv[j];
  }
}

#define XB_TMO      128
#define XB_XCNT(j)  (256  + 64 * (j))
#define XB_XSUB(j)  (1280 + 64 * (j))
#define XB_XGEN(j)  (2304 + 64 * (j))
#define XB_TOP      3328
#define XB_TOPGEN   3392
#define XCD_BAR_WORDS 3456
#define XB_SPIN_CAP (1u << 18)

__device__ __forceinline__ unsigned xb_ld(unsigned* p)              { return __hip_atomic_load(p, __ATOMIC_RELAXED, __HIP_MEMORY_SCOPE_AGENT); }
__device__ __forceinline__ unsigned xb_add(unsigned* p, unsigned v) { return __hip_atomic_fetch_add(p, v, __ATOMIC_RELAXED, __HIP_MEMORY_SCOPE_AGENT); }
__device__ __forceinline__ unsigned xb_xcc_id() { return (unsigned)__builtin_amdgcn_s_getreg((3 << 11) | 20) & 0xFu; }
#define XB_SPIN(cond, bar) do { unsigned _sp = 0; while (cond) { __builtin_amdgcn_s_sleep(1); \
    if ((++_sp & 255u) == 0u) { if (xb_ld(&(bar)[XB_TMO])) break; if (_sp > XB_SPIN_CAP) { atomicAdd(&(bar)[XB_TMO], 1u); break; } } } } while (0)

struct XcdBarrier {
    unsigned* bar; unsigned x;
    volatile LAS unsigned* st;
};

__device__ __forceinline__ XcdBarrier xcd_barrier_post(unsigned* bar, volatile LAS unsigned* st) {
    XcdBarrier b; b.bar = bar; b.x = xb_xcc_id(); b.st = st;
    if (threadIdx.x == 0) (void)xb_add(&bar[XB_XCNT(b.x)], 1u);
    return b;
}
__device__ __forceinline__ void xcd_barrier_complete(unsigned* bar, unsigned x, unsigned& nloc, unsigned& nx) {
    const unsigned G = gridDim.x * gridDim.y * gridDim.z;
    unsigned sum, cnt, mine, sp = 0u;
    for (;;) {
        sum = 0u; cnt = 0u; mine = 0u;
#pragma unroll
        for (unsigned j = 0; j < 16; ++j) { const unsigned c = xb_ld(&bar[XB_XCNT(j)]); sum += c; cnt += (c > 0u) ? 1u : 0u; mine = (j == x) ? c : mine; }
        if (sum == G) break;
        __builtin_amdgcn_s_sleep(1);
        if ((++sp & 255u) == 0u) { if (xb_ld(&bar[XB_TMO])) break; if (sp > XB_SPIN_CAP) { atomicAdd(&bar[XB_TMO], 1u); break; } }
    }
    nloc = mine > 0u ? mine : 1u; nx = cnt > 0u ? cnt : 1u;
}

__device__ __forceinline__ void xcd_barrier(const XcdBarrier& b) {
    asm volatile("s_waitcnt vmcnt(0)" ::: "memory");
    __syncthreads();
    if (threadIdx.x == 0) {
        unsigned* bar = b.bar;
        __builtin_amdgcn_s_waitcnt(0);
        unsigned nloc = b.st[0], nx = b.st[1];
        if (nloc == 0u) { xcd_barrier_complete(bar, b.x, nloc, nx); b.st[0] = nloc; b.st[1] = nx; }
        const unsigned old = xb_add(&bar[XB_XSUB(b.x)], 1u);
        const unsigned gen = old / nloc;
        if (old + 1u == (gen + 1u) * nloc) {
            __builtin_amdgcn_fence(__ATOMIC_RELEASE, "agent");
            asm volatile("s_waitcnt vmcnt(0)" ::: "memory");
            const unsigned og = xb_add(&bar[XB_TOP], 1u);
            const unsigned tg = og / nx;
            if (og + 1u == (tg + 1u) * nx) xb_add(&bar[XB_TOPGEN], 1u);
            else XB_SPIN(xb_ld(&bar[XB_TOPGEN]) == tg, bar);
            __builtin_amdgcn_fence(__ATOMIC_ACQUIRE, "agent");
            xb_add(&bar[XB_XGEN(b.x)], 1u);
            asm volatile("s_waitcnt vmcnt(0)" ::: "memory");
        } else {
            XB_SPIN(xb_ld(&bar[XB_XGEN(b.x)]) == gen, bar);
            __builtin_amdgcn_fence(__ATOMIC_ACQUIRE, "agent");
            asm volatile("s_waitcnt vmcnt(0)" ::: "memory");
        }
    }
    __syncthreads();
}

#ifndef PHMASK
#define PHMASK 255
#endif
#ifndef REPMASK
#define REPMASK 0
#endif
__global__ void __launch_bounds__(NTHREADS, 2) hybrid_fwd(Args a) {
  extern __shared__ __attribute__((aligned(16))) unsigned char lds_raw[];
  LAS unsigned char* lds = (LAS unsigned char*)lds_raw;
  cg::grid_group grid = cg::this_grid();
  const int tid = threadIdx.x;
  if (a.ws == nullptr) grid.sync();
  bf16_t* BTIN = (bf16_t*)(a.ws + WS_BTIN); bf16_t* BTOUT = (bf16_t*)(a.ws + WS_BTOUT);
  bf16_t* XN = (bf16_t*)(a.ws + WS_XN); bf16_t* H = (bf16_t*)(a.ws + WS_H); bf16_t* MIX = (bf16_t*)(a.ws + WS_MIX);
  float* IW = (float*)(a.ws + WS_IW); float* YPRE = (float*)(a.ws + WS_YPRE);
  int* NSEL = (int*)(a.ws + WS_NSEL); unsigned short* SEL = (unsigned short*)(a.ws + WS_SEL);
  unsigned* ctl = (unsigned*)(a.ws + WS_CTL);
  volatile LAS unsigned* bst = (volatile LAS unsigned*)(lds + L_BAR);
  if (tid < 2) bst[tid] = 0u;
  __syncthreads();
  const XcdBarrier bar = xcd_barrier_post(ctl + 1024, bst);
  if (PHMASK & 1) for (int rep = 0; rep < ((REPMASK & 1) ? 2 : 1); ++rep) p0_prologue(a, lds);
  xcd_barrier(bar);
  if (PHMASK & 2) {
    pg8::Gemm g{XN, BTIN, M, NPAD, DM}; pg8::StaticOrder S; S.init(M, NPAD, (int)gridDim.x, (int)blockIdx.x);
    EpiInProj E{H, IW, a.b_in, (const f32x2*)(a.ws + WS_CS)};
    pg8::gemm_phase<EpiInProj, pg8::StaticOrder, true, true>(lds, g, S, E);
  }
  if (REPMASK & 2) {
    pg8::Gemm g{XN, BTIN, M, NPAD, DM}; pg8::StaticOrder S; S.init(M, NPAD, (int)gridDim.x, (int)blockIdx.x);
    EpiInProj E{H, IW, a.b_in, (const f32x2*)(a.ws + WS_CS)};
    pg8::gemm_phase<EpiInProj, pg8::StaticOrder, true, true>(lds, g, S, E);
  }
  xcd_barrier(bar);
  if (PHMASK & 4) {
    LAS int* us = (LAS int*)(lds + L_UNIT);
    if (PHMASK & 64) for (int rep = 0; rep < ((REPMASK & 64) ? 2 : 1); ++rep) for (;;) {
      if (tid == 0) *us = (int)__hip_atomic_fetch_add(ctl + 128 * rep, 1u, __ATOMIC_RELAXED, __HIP_MEMORY_SCOPE_AGENT);
      __syncthreads();
      const int u = *us;
      __syncthreads();
      if (u >= 512) break;
      indexer_unit(lds, u, H, IW, SEL, NSEL);
    }
    if (PHMASK & 128) for (int rep = 0; rep < ((REPMASK & 128) ? 2 : 1); ++rep) for (;;) {
      if (tid == 0) *us = (int)__hip_atomic_fetch_add(ctl + 64 + 128 * rep, 1u, __ATOMIC_RELAXED, __HIP_MEMORY_SCOPE_AGENT);
      __syncthreads();
      const int u = *us;
      __syncthreads();
      if (u >= 512) break;
      swa_unit(lds, u, H, a.sinks, MIX);
    }
  }
  xcd_barrier(bar);
  if (PHMASK & 8) for (int rep = 0; rep < ((REPMASK & 8) ? 2 : 1); ++rep) sparse_attn_phase(lds, H, SEL, NSEL, MIX);
  xcd_barrier(bar);
  if (PHMASK & 16) for (int rep = 0; rep < ((REPMASK & 16) ? 2 : 1); ++rep) {
    pg8::Gemm g{MIX, BTOUT, M, DM, DM}; pg8::StaticOrder S; S.init(M, DM, (int)gridDim.x, (int)blockIdx.x);
    EpiOutProj E{YPRE, a.b_out, a.x};
    pg8::gemm_phase<EpiOutProj, pg8::StaticOrder, true, true>(lds, g, S, E);
  }
  xcd_barrier(bar);
  if (PHMASK & 32) for (int rep = 0; rep < ((REPMASK & 32) ? 2 : 1); ++rep) ln_phase(YPRE, a.ln_g, a.ln_b, a.out);
}

extern "C" void kernel_launch(void* const* d_in, const int* in_sizes, int n_in, void* d_out, int out_size, void* d_ws, size_t ws_size, hipStream_t stream) {
  static int grid = 0;
  if (grid == 0) {
    if (n_in != 9 || ws_size < WS_END) { fprintf(stderr, "kernel_launch: unexpected inputs (n_in %d, ws %zu)\n", n_in, ws_size); grid = -1; return; }
    int dev = 0, cus = 0, per_cu = 0;
    (void)hipGetDevice(&dev); (void)hipDeviceGetAttribute(&cus, hipDeviceAttributeMultiprocessorCount, dev);
    if (hipFuncSetAttribute((const void*)hybrid_fwd, hipFuncAttributeMaxDynamicSharedMemorySize, LDS_BYTES) != hipSuccess) { fprintf(stderr, "kernel_launch: hipFuncSetAttribute failed\n"); grid = -1; return; }
    (void)hipOccupancyMaxActiveBlocksPerMultiprocessor(&per_cu, (const void*)hybrid_fwd, NTHREADS, LDS_BYTES);
    if (per_cu < 1) { fprintf(stderr, "kernel_launch: occupancy query says %d blocks per CU\n", per_cu); per_cu = 1; }
    (void)hipGetLastError();
    grid = cus;
  }
  if (grid < 0) return;
  (void)hipMemsetAsync((char*)d_ws + WS_CTL, 0, 32768, stream);
  Args a{};
  a.x = (const float*)d_in[0]; a.pos = (const int*)d_in[1]; a.w_in = (const float*)d_in[2]; a.b_in = (const float*)d_in[3]; a.sinks = (const float*)d_in[4];
  a.w_out = (const float*)d_in[5]; a.b_out = (const float*)d_in[6]; a.ln_g = (const float*)d_in[7]; a.ln_b = (const float*)d_in[8];
  a.out = (float*)d_out; a.ws = (unsigned char*)d_ws;
  void* args[] = {&a};
  hipError_t e = hipLaunchCooperativeKernel((const void*)hybrid_fwd, dim3(grid), dim3(NTHREADS), args, LDS_BYTES, stream);
  if (e != hipSuccess) fprintf(stderr, "kernel_launch: cooperative launch failed: %s (grid %d)\n", hipGetErrorString(e), grid);
}
```

```cpp
#include <hip/hip_runtime.h>
#include <hip/hip_cooperative_groups.h>
#include <cstdio>
#include <cstdint>
namespace cg = cooperative_groups;
namespace pg8 {
#define PG8_LAS __attribute__((address_space(3)))
typedef unsigned short bf16_t;
typedef short bf16x8 __attribute__((ext_vector_type(8)));
typedef float f32x4 __attribute__((ext_vector_type(4)));
typedef unsigned u32x4 __attribute__((ext_vector_type(4)));
constexpr int BM = 256, BK = 64, HALF = 128, HTB = HALF * BK * 2  , STAGE_BYTES = 8 * HTB, NXCD = 8, WGM = 8;

__host__ __device__ __forceinline__ int lds_byte(int r, int c) { const int st = (r >> 4) * 2 + (c >> 5), rr = r & 15, cc = c & 31, ob = rr * 64 + cc * 2; return st * 1024 + (ob ^ (((ob >> 9) & 1) << 5)); }
__host__ __device__ __forceinline__ void stage_rc(int b, int& R, int& C) { const int st = b / 1024, sb = b % 1024, swz = sb ^ (((sb >> 9) & 1) << 5); R = (st >> 1) * 16 + swz / 64; C = (st & 1) * 32 + (swz % 64) / 2; }
__host__ __device__ __forceinline__ int perm32(int rho) { const int n = rho >> 4, i = rho & 15; return 8 * (i >> 2) + 4 * n + (i & 3); }

struct Unit { int pm, pn; };
struct Gemm { const bf16_t* A; const bf16_t* Bt; int M, N, K; };

struct StaticOrder {
    int nM, nN, nwg, G, c;
    __host__ __device__ void init(int M, int N, int G_, int c_) { nM = M / BM; nN = N / BM; nwg = nM * nN; G = G_; c = c_; }
    __host__ __device__ bool next(int i, Unit& u) const {
        const long L = (long)i * G + c; if (L >= nwg) return false;
        int wgid = (int)L; { const int q = nwg / NXCD, r = nwg % NXCD, xcd = wgid % NXCD, off = wgid / NXCD; wgid = (xcd < r ? xcd * (q + 1) : r * (q + 1) + (xcd - r) * q) + off; }
        const int nig = WGM * nN, gid = wgid / nig, fm = gid * WGM, gsz = (nM - fm) < WGM ? (nM - fm) : WGM;
        u.pm = fm + ((wgid % nig) % gsz); u.pn = (wgid % nig) / gsz; return true;
    }
    __device__ __forceinline__ void a_ready(const Unit&) const {}
    __device__ __forceinline__ void done(const Unit&) const {}
};

__device__ __forceinline__ unsigned cvt_pk_bf16(float lo, float hi) { unsigned r; asm volatile("v_cvt_pk_bf16_f32 %0, %1, %2" : "=v"(r) : "v"(lo), "v"(hi)); return r; }
template <class Epi, class Sched, bool ALIGN_EPI = false, bool SP2 = false>
__device__ __forceinline__ void gemm_phase(PG8_LAS unsigned char* lds, const Gemm g, const Sched& S, const Epi& E) {
    const int tid = threadIdx.x, wid = __builtin_amdgcn_readfirstlane(tid >> 6), lane = tid & 63, wr = wid >> 2, wc = wid & 3, fr = lane & 15, fq = lane >> 4;
    const int K = g.K, nt = K / BK;
    unsigned voffA[2], voffB[2];
#pragma unroll
    for (int i = 0; i < 2; ++i) { int R, C; stage_rc(tid * 16 + i * 8192, R, C); const int Rb = Epi::PERM ? ((R & ~31) + perm32(R & 31)) : R;
        voffA[i] = (unsigned)(R * K + C) * 2u; voffB[i] = (unsigned)(Rb * K + C) * 2u; }
    const size_t kstep = (size_t)(BK * 2);
    const size_t hstep = (size_t)HALF * K * 2;
    const size_t tstep = 2 * hstep;
    const unsigned ldsw = (unsigned)wid * 1024u;
    const int aoff = lds_byte(wr * 64 + fr, fq * 8), boff = lds_byte(wc * 32 + fr, fq * 8);
#define PG8_SA(b, h) (((b) * 2 + (h)) * HTB)
#define PG8_SB(b, h) ((4 + (b) * 2 + (h)) * HTB)
#define PG8_STAGE(bufoff, gbase, voff) do { _Pragma("unroll") for (int _i = 0; _i < 2; ++_i) \
        __builtin_amdgcn_global_load_lds((const unsigned*)((const char*)(gbase) + (voff)[_i]), (PG8_LAS unsigned*)(lds + (bufoff) + ldsw + _i * 8192), 16, 0, 0); } while (0)
#define PG8_LDA(dst, b, h) do { _Pragma("unroll") for (int m = 0; m < 4; ++m) _Pragma("unroll") for (int k = 0; k < 2; ++k) dst[m][k] = *(const PG8_LAS bf16x8*)(lds + PG8_SA(b, h) + aoff + m * 2048 + k * 1024); } while (0)
#define PG8_LDB(dst, b, h) do { _Pragma("unroll") for (int n = 0; n < 2; ++n) _Pragma("unroll") for (int k = 0; k < 2; ++k) dst[n][k] = *(const PG8_LAS bf16x8*)(lds + PG8_SB(b, h) + boff + n * 2048 + k * 1024); } while (0)
#define PG8_MMA(ai, bj, At, Bt) do { __builtin_amdgcn_s_setprio(1); _Pragma("unroll") for (int m = 0; m < 4; ++m) _Pragma("unroll") for (int n = 0; n < 2; ++n) _Pragma("unroll") for (int k = 0; k < 2; ++k) \
        acc[ai][bj][m][n] = __builtin_amdgcn_mfma_f32_16x16x32_bf16(Bt[n][k], At[m][k], acc[ai][bj][m][n], 0, 0, 0); __builtin_amdgcn_s_setprio(0); } while (0)
#define PG8_WAIT_V(n) asm volatile("s_waitcnt vmcnt(" #n ")" ::: "memory")
#define PG8_WAIT_L(n) asm volatile("s_waitcnt lgkmcnt(" #n ")" ::: "memory")
#define PG8_BAR __builtin_amdgcn_s_barrier()
#define PG8_SCHED __builtin_amdgcn_sched_barrier(0)
    Unit cur, nxt; int ui = 0;
    if (!S.next(0, cur)) return;
    f32x4 acc[2][2][4][2];
#pragma unroll
    for (int a = 0; a < 2; ++a)
#pragma unroll
        for (int b = 0; b < 2; ++b)
#pragma unroll
            for (int m = 0; m < 4; ++m)
#pragma unroll
                for (int n = 0; n < 2; ++n) acc[a][b][m][n] = (f32x4){0.f, 0.f, 0.f, 0.f};
    bf16x8 At[4][2], B0[2][2], B1[2][2];
    const char* cA = (const char*)g.A + (size_t)cur.pm * tstep; const char* cB = (const char*)g.Bt + (size_t)cur.pn * tstep;
    S.a_ready(cur);
    if constexpr (SP2) {
        PG8_STAGE(PG8_SB(0, 0), cB, voffB); PG8_STAGE(PG8_SB(0, 1), cB + hstep, voffB); PG8_STAGE(PG8_SA(0, 0), cA, voffA); PG8_STAGE(PG8_SA(0, 1), cA + hstep, voffA);
        if (wr == 1) PG8_BAR;
        PG8_WAIT_V(2); PG8_BAR;
        PG8_STAGE(PG8_SB(1, 0), cB + kstep, voffB); PG8_STAGE(PG8_SA(1, 0), cA + kstep, voffA); PG8_STAGE(PG8_SB(1, 1), cB + hstep + kstep, voffB);
        PG8_WAIT_V(6); PG8_BAR;
    } else {
        PG8_STAGE(PG8_SB(0, 0), cB, voffB); PG8_STAGE(PG8_SA(0, 0), cA, voffA); PG8_STAGE(PG8_SB(0, 1), cB + hstep, voffB); PG8_STAGE(PG8_SA(0, 1), cA + hstep, voffA);
        if (wr == 1) PG8_BAR;
        PG8_WAIT_V(4); PG8_BAR;
        PG8_STAGE(PG8_SB(1, 0), cB + kstep, voffB); PG8_STAGE(PG8_SA(1, 0), cA + kstep, voffA); PG8_STAGE(PG8_SB(1, 1), cB + hstep + kstep, voffB);
        PG8_WAIT_V(6); PG8_BAR;
    }
    for (;;) {
        const bool has_next = S.next(ui + 1, nxt);
        const char* nA = has_next ? (const char*)g.A + (size_t)nxt.pm * tstep : cA; const char* nB = has_next ? (const char*)g.Bt + (size_t)nxt.pn * tstep : cB;
        for (int t = 0; t < nt; t += 2) {
            const bool last = (t == nt - 2);
            const char* a1 = cA + (size_t)(t + 1) * kstep;
            const char* a2 = last ? nA : cA + (size_t)(t + 2) * kstep; const char* b2 = last ? nB : cB + (size_t)(t + 2) * kstep;
            const char* a3 = a2 + kstep; const char* b3 = b2 + kstep;
            if (last && has_next) S.a_ready(nxt);
            if constexpr (SP2) {
            PG8_LDB(B0, 0, 0); PG8_LDB(B1, 0, 1); PG8_SCHED; PG8_LDA(At, 0, 0); PG8_STAGE(PG8_SA(1, 1), a1 + hstep, voffA);
            PG8_WAIT_V(8); PG8_WAIT_L(0); PG8_BAR; PG8_MMA(0, 0, At, B0); PG8_MMA(0, 1, At, B1); PG8_BAR; PG8_SCHED;
            PG8_LDA(At, 0, 1); PG8_STAGE(PG8_SB(0, 0), b2, voffB); PG8_STAGE(PG8_SB(0, 1), b2 + hstep, voffB); PG8_STAGE(PG8_SA(0, 0), a2, voffA);
            PG8_WAIT_V(8); PG8_WAIT_L(0); PG8_BAR; PG8_MMA(1, 0, At, B0); PG8_MMA(1, 1, At, B1); PG8_BAR; PG8_SCHED;
            PG8_LDB(B0, 1, 0); PG8_LDB(B1, 1, 1); PG8_SCHED; PG8_LDA(At, 1, 0); PG8_STAGE(PG8_SA(0, 1), a2 + hstep, voffA);
            PG8_WAIT_V(8); PG8_WAIT_L(0); PG8_BAR; PG8_MMA(0, 0, At, B0); PG8_MMA(0, 1, At, B1); PG8_BAR; PG8_SCHED;
            PG8_LDA(At, 1, 1); PG8_STAGE(PG8_SB(1, 0), b3, voffB); PG8_STAGE(PG8_SB(1, 1), b3 + hstep, voffB); PG8_STAGE(PG8_SA(1, 0), a3, voffA);
            PG8_WAIT_V(8); PG8_WAIT_L(0); PG8_BAR; PG8_MMA(1, 0, At, B0); PG8_MMA(1, 1, At, B1); PG8_BAR; PG8_SCHED;
            } else {
            PG8_LDB(B0, 0, 0); PG8_SCHED; PG8_LDA(At, 0, 0); PG8_STAGE(PG8_SA(1, 1), a1 + hstep, voffA);
            PG8_WAIT_L(8); PG8_BAR; PG8_WAIT_L(0); PG8_MMA(0, 0, At, B0); PG8_BAR; PG8_SCHED;
            PG8_LDB(B1, 0, 1); PG8_STAGE(PG8_SB(0, 0), b2, voffB);
            PG8_BAR; PG8_WAIT_L(0); PG8_MMA(0, 1, At, B1); PG8_BAR;
            PG8_LDA(At, 0, 1); PG8_STAGE(PG8_SA(0, 0), a2, voffA);
            PG8_BAR; PG8_WAIT_L(0); PG8_MMA(1, 0, At, B0); PG8_BAR; PG8_SCHED;
            PG8_STAGE(PG8_SB(0, 1), b2 + hstep, voffB);
            PG8_WAIT_V(6); PG8_BAR; PG8_MMA(1, 1, At, B1); PG8_BAR;
            PG8_LDB(B0, 1, 0); PG8_SCHED; PG8_LDA(At, 1, 0); PG8_STAGE(PG8_SA(0, 1), a2 + hstep, voffA);
            PG8_WAIT_L(8); PG8_BAR; PG8_WAIT_L(0); PG8_MMA(0, 0, At, B0); PG8_BAR; PG8_SCHED;
            PG8_LDB(B1, 1, 1); PG8_STAGE(PG8_SB(1, 0), b3, voffB);
            PG8_BAR; PG8_WAIT_L(0); PG8_MMA(0, 1, At, B1); PG8_BAR;
            PG8_LDA(At, 1, 1); PG8_STAGE(PG8_SA(1, 0), a3, voffA);
            PG8_BAR; PG8_WAIT_L(0); PG8_MMA(1, 0, At, B0); PG8_BAR; PG8_SCHED;
            PG8_STAGE(PG8_SB(1, 1), b3 + hstep, voffB);
            PG8_WAIT_V(6); PG8_BAR; PG8_MMA(1, 1, At, B1); PG8_BAR;
            }
        }
        if constexpr (ALIGN_EPI) { if (wr == 0) PG8_BAR; }
        if constexpr (!Epi::AFTER_DRAIN) { E(acc, cur, wr, wc, fr, fq); S.done(cur); }
        if (!has_next) break;
#pragma unroll
        for (int a = 0; a < 2; ++a)
#pragma unroll
            for (int b = 0; b < 2; ++b)
#pragma unroll
                for (int m = 0; m < 4; ++m)
#pragma unroll
                    for (int n = 0; n < 2; ++n) acc[a][b][m][n] = (f32x4){0.f, 0.f, 0.f, 0.f};
        cur = nxt; cA = nA; cB = nB; ++ui;
        if constexpr (ALIGN_EPI) { if (wr == 1) PG8_BAR; }
    }
    PG8_WAIT_V(0);
    if constexpr (!ALIGN_EPI) { if (wr == 0) PG8_BAR; }
    PG8_BAR;
    if constexpr (Epi::AFTER_DRAIN) { E.fused(acc, cur, wr, wc, fr, fq, lds, wid, lane); S.done(cur); }
#undef PG8_SA
#undef PG8_SB
#undef PG8_STAGE
#undef PG8_LDA
#undef PG8_LDB
#undef PG8_MMA
#undef PG8_WAIT_V
#undef PG8_WAIT_L
#undef PG8_BAR
#undef PG8_SCHED
}
}
#define LAS __attribute__((address_space(3)))
typedef unsigned short bf16_t;
typedef short bf16x8 __attribute__((ext_vector_type(8)));
typedef short s16x4 __attribute__((ext_vector_type(4)));
typedef float f32x4 __attribute__((ext_vector_type(4)));
typedef float f32x2 __attribute__((ext_vector_type(2)));
typedef float f32x16 __attribute__((ext_vector_type(16)));
typedef unsigned u32x4 __attribute__((ext_vector_type(4)));
typedef unsigned u32x2 __attribute__((ext_vector_type(2)));
using pg8::cvt_pk_bf16;

constexpr int SEQ = 8192, NB = 2, M = NB * SEQ, DM = 1024, NCOL = 2756, NPAD = 2816, HP = 2752;
constexpr int C_AQ = 0, C_AK = 512, C_AV = 640, C_AG = 768, C_BQ = 1280, C_BK = 1792, C_BV = 1856, C_BG = 1920, C_IQ = 2432, C_IK = 2688, C_IW = 2752;
constexpr float LOG2E = 1.4426950408889634f, QSCALE = 0.125f * LOG2E, LN_EPS = 1e-5f;
constexpr float ALPHA = 1.189207115002721f;
constexpr size_t MiB = 1u << 20;
constexpr size_t WS_CTL = 0, WS_BTIN = 2 * MiB, WS_BTOUT = 8 * MiB, WS_CS = 10 * MiB, WS_IW = 14 * MiB, WS_NSEL = 15 * MiB, WS_SEL = 16 * MiB,
                 WS_XN = 24 * MiB, WS_H = 56 * MiB, WS_MIX = 142 * MiB, WS_YPRE = 174 * MiB, WS_END = 238 * MiB;
constexpr int LDS_BYTES = 160768;
constexpr int NTHREADS = 512, NWAVES = 8;
#define MFMA32(a, b, c) __builtin_amdgcn_mfma_f32_32x32x16_bf16((a), (b), (c), 0, 0, 0)
#define LDSWAIT() asm volatile("s_waitcnt lgkmcnt(0)" ::: "memory")

__device__ __forceinline__ int crow(int i, int h) { return (i & 3) + 8 * (i >> 2) + 4 * h; }
__device__ __forceinline__ int swap45(int c) { return (c & ~48) | ((c & 16) << 1) | ((c & 32) >> 1); }
__device__ __forceinline__ float bf2f(unsigned short b) { return __uint_as_float((unsigned)b << 16); }
__device__ __forceinline__ bf16x8 ldg16(const bf16_t* p) { return *(const bf16x8*)p; }
__device__ __forceinline__ bf16x8 pack8(const f32x16& x, int s) {
  u32x4 p; p.x = cvt_pk_bf16(x[8 * s + 0], x[8 * s + 1]); p.y = cvt_pk_bf16(x[8 * s + 2], x[8 * s + 3]); p.z = cvt_pk_bf16(x[8 * s + 4], x[8 * s + 5]); p.w = cvt_pk_bf16(x[8 * s + 6], x[8 * s + 7]);
  return __builtin_bit_cast(bf16x8, p);
}
__device__ __forceinline__ float relu1(float x) { return __builtin_amdgcn_fmed3f(x, 0.f, __builtin_inff()); }
__device__ __forceinline__ s16x4 tr_read(LAS unsigned char* p) { return __builtin_amdgcn_ds_read_tr16_b64_v4i16((LAS s16x4*)p); }

struct Args { const float* x; const int* pos; const float* w_in; const float* b_in; const float* sinks; const float* w_out; const float* b_out; const float* ln_g; const float* ln_b;
              float* out; unsigned char* ws; };

__device__ __forceinline__ void p0_transpose_item(const float* W, int N, bf16_t* WT, bool perm, LAS float* scr, int item, int nblk, int lane) {
  const int kb = item / nblk, nb = item % nblk, k0 = 64 * kb, n0 = 32 * nb;
  const int nn = n0 + (lane & 31);
#pragma unroll 8
  for (int i = 0; i < 32; ++i) { const int kk = 2 * i + (lane >> 5); scr[kk * 33 + (lane & 31)] = nn < N ? W[(size_t)(k0 + kk) * N + nn] : 0.f; }
  LDSWAIT();
  const int c = lane & 7;
#pragma unroll
  for (int j = 0; j < 4; ++j) { const int n = (lane >> 3) + 8 * j; const LAS float* s = scr + (8 * c) * 33 + n;
    u32x4 o; o.x = cvt_pk_bf16(s[0 * 33], s[1 * 33]); o.y = cvt_pk_bf16(s[2 * 33], s[3 * 33]); o.z = cvt_pk_bf16(s[4 * 33], s[5 * 33]); o.w = cvt_pk_bf16(s[6 * 33], s[7 * 33]);
    const int grow = perm ? swap45(n0 + n) : (n0 + n);
    *(u32x4*)(WT + (size_t)grow * 1024 + k0 + 8 * c) = o; }
  LDSWAIT();
}
__device__ __forceinline__ void p0_prologue(const Args& a, LAS unsigned char* lds) {
  const int tid = threadIdx.x, lane = tid & 63, wid = tid >> 6;
  const int gw = blockIdx.x * NWAVES + wid, NGW = gridDim.x * NWAVES;
  LAS float* scr = (LAS float*)(lds + wid * 16384);
  bf16_t* BTIN = (bf16_t*)(a.ws + WS_BTIN); bf16_t* BTOUT = (bf16_t*)(a.ws + WS_BTOUT);
  constexpr int NBI = NPAD / 32, I_IN = 16 * NBI, I_OUT = 16 * 32;
  for (int it = gw; it < I_IN + I_OUT; it += NGW) {
    if (it < I_IN) p0_transpose_item(a.w_in, NCOL, BTIN, true, scr, it, NBI, lane);
    else p0_transpose_item(a.w_out, DM, BTOUT, false, scr, it - I_IN, 32, lane);
  }
  const int gt = blockIdx.x * NTHREADS + tid, NGT = gridDim.x * NTHREADS;
  bf16_t* XN = (bf16_t*)(a.ws + WS_XN);
  for (int i = gt; i < M * DM / 8; i += NGT) {
    const f32x4 v0 = *(const f32x4*)(a.x + (size_t)i * 8), v1 = *(const f32x4*)(a.x + (size_t)i * 8 + 4);
    u32x4 o; o.x = cvt_pk_bf16(v0[0], v0[1]); o.y = cvt_pk_bf16(v0[2], v0[3]); o.z = cvt_pk_bf16(v1[0], v1[1]); o.w = cvt_pk_bf16(v1[2], v1[3]);
    *(u32x4*)(XN + (size_t)i * 8) = o;
  }
  f32x2* CS = (f32x2*)(a.ws + WS_CS);
  for (int i = gt; i < M * 32; i += NGT) {
    const int row = i >> 5, j = i & 31;
    const float inv = exp2f(-(float)j * (13.287712379549449f / 32.0f));
    const float ang = (float)a.pos[row] * inv;
    CS[i] = (f32x2){cosf(ang), sinf(ang)};
  }
}

struct EpiInProj {
  static constexpr bool PERM = false, AFTER_DRAIN = false;
  bf16_t* H; float* IW; const float* bias; const f32x2* CS;
  __device__ __forceinline__ void operator()(const f32x4 (&acc)[2][2][4][2], const pg8::Unit& u, int wr, int wc, int fr, int fq) const {
    const int row0 = u.pm * 256 + wr * 64 + fr;
    const int dloc = 16 * (wc & 1) + 4 * fq;
#pragma unroll
    for (int bj = 0; bj < 2; ++bj) {
      const int G = 4 * u.pn + 2 * bj + (wc >> 1);
      if (G >= 44) continue;
      const int col1 = 64 * G + dloc;
      if (G == 43) {
        if (dloc == 0) {
          const f32x4 b1 = *(const f32x4*)(bias + col1);
#pragma unroll
          for (int ai = 0; ai < 2; ++ai)
#pragma unroll
            for (int m = 0; m < 4; ++m) { const int row = row0 + 128 * ai + 16 * m; *(f32x4*)(IW + (size_t)row * 4) = (acc[ai][bj][m][0] + b1) * 0.0625f; }
        }
        continue;
      }
      const f32x4 b1 = *(const f32x4*)(bias + col1), b2 = *(const f32x4*)(bias + col1 + 32);
      const bool rope = (G < 10) || (G >= 20 && G < 29) || (G >= 38);
      const bool silu = (G >= 12 && G < 20) || (G >= 30 && G < 38);
      const float sc = ((G < 8) || (G >= 20 && G < 28)) ? QSCALE : 1.0f;
#pragma unroll
      for (int ai = 0; ai < 2; ++ai)
#pragma unroll
        for (int m = 0; m < 4; ++m) {
          const int row = row0 + 128 * ai + 16 * m;
          f32x4 v1 = acc[ai][bj][m][0] + b1, v2 = acc[ai][bj][m][1] + b2;
          if (rope) {
            const f32x4 cs0 = *(const f32x4*)((const float*)CS + ((size_t)row * 32 + dloc) * 2), cs1 = *(const f32x4*)((const float*)CS + ((size_t)row * 32 + dloc) * 2 + 4);
            const f32x4 c = {cs0[0], cs0[2], cs1[0], cs1[2]}, s = {cs0[1], cs0[3], cs1[1], cs1[3]};
            const f32x4 o1 = v1 * c - v2 * s, o2 = v2 * c + v1 * s;
            v1 = o1 * sc; v2 = o2 * sc;
          } else if (silu) {
#pragma unroll
            for (int i = 0; i < 4; ++i) { v1[i] = v1[i] * __builtin_amdgcn_rcpf(1.0f + __builtin_amdgcn_exp2f(-LOG2E * v1[i])); v2[i] = v2[i] * __builtin_amdgcn_rcpf(1.0f + __builtin_amdgcn_exp2f(-LOG2E * v2[i])); }
          }
          u32x2 w1, w2; w1.x = cvt_pk_bf16(v1[0], v1[1]); w1.y = cvt_pk_bf16(v1[2], v1[3]); w2.x = cvt_pk_bf16(v2[0], v2[1]); w2.y = cvt_pk_bf16(v2[2], v2[3]);
          bf16_t* p = H + (size_t)row * HP + col1;
          *(u32x2*)p = w1; *(u32x2*)(p + 32) = w2;
        }
    }
  }
};
struct EpiOutProj {
  static constexpr bool PERM = false, AFTER_DRAIN = false;
  float* Y; const float* bias; const float* x;
  __device__ __forceinline__ void operator()(const f32x4 (&acc)[2][2][4][2], const pg8::Unit& u, int wr, int wc, int fr, int fq) const {
    const int row0 = u.pm * 256 + wr * 64 + fr, col0 = u.pn * 256 + wc * 32 + 4 * fq;
#pragma unroll
    for (int bj = 0; bj < 2; ++bj)
#pragma unroll
      for (int n = 0; n < 2; ++n) { const int col = col0 + 128 * bj + 16 * n; const f32x4 bv = *(const f32x4*)(bias + col);
#pragma unroll
        for (int ai = 0; ai < 2; ++ai)
#pragma unroll
          for (int m = 0; m < 4; ++m) { const size_t off = (size_t)(row0 + 128 * ai + 16 * m) * DM + col;
            *(f32x4*)(Y + off) = acc[ai][bj][m][n] + bv + ALPHA * *(const f32x4*)(x + off); } }
  }
};
__device__ __forceinline__ void swa_unit(LAS unsigned char* lds, int u, const bf16_t* H, const float* sinks, bf16_t* MIX) {
  const int tid = threadIdx.x, lane = tid & 63, wid = __builtin_amdgcn_readfirstlane(tid >> 6), r = lane & 31, h = lane >> 5;
  const int g = u & 1, qb = (u >> 1) & 127, b = u >> 8;
  const size_t rowbase = (size_t)b * SEQ;
  const int t00 = qb * 64, kbase = t00 - 128;
  for (int i = tid; i < 192 * 8; i += NTHREADS) {
    const int kl = i >> 3, piece = i & 7, key = kbase + kl;
    u32x4 v = {0u, 0u, 0u, 0u};
    if (key >= 0) v = *(const u32x4*)(H + (rowbase + key) * HP + C_AV + g * 64 + piece * 8);
    *(LAS u32x4*)(lds + kl * 128 + piece * 16) = v;
  }
  __syncthreads();
  const int r4 = wid & 3, sub = wid >> 2, hq = g * 4 + r4, t0 = t00 + 32 * sub;
  bf16x8 Bq[4];
#pragma unroll
  for (int ks = 0; ks < 4; ++ks) Bq[ks] = ldg16(H + (rowbase + t0 + r) * HP + C_AQ + hq * 64 + 16 * ks + 8 * h);
  f32x16 S[5];
#pragma unroll
  for (int tl = 0; tl < 5; ++tl) {
    const int key = t0 - 128 + 32 * tl + r, kc = key < 0 ? 0 : key;
    f32x16 acc;
#pragma unroll
    for (int i = 0; i < 16; ++i) acc[i] = 0.f;
#pragma unroll
    for (int ks = 0; ks < 4; ++ks) { const bf16x8 A = ldg16(H + (rowbase + kc) * HP + C_AK + g * 64 + 16 * ks + 8 * h); acc = MFMA32(A, Bq[ks], acc); }
    S[tl] = acc;
  }
  const float sk = sinks[hq] * LOG2E;
  float mx = sk;
#pragma unroll
  for (int tl = 0; tl < 5; ++tl)
#pragma unroll
    for (int i = 0; i < 16; ++i) {
      const int rel = r + 128 - 32 * tl - crow(i, h), key = t0 + r - rel;
      const bool valid = rel >= 0 && rel < 128 && key >= 0;
      S[tl][i] = valid ? S[tl][i] : -INFINITY;
      mx = fmaxf(mx, S[tl][i]);
    }
  mx = fmaxf(mx, __shfl_xor(mx, 32));
  float sum = 0.f;
#pragma unroll
  for (int tl = 0; tl < 5; ++tl)
#pragma unroll
    for (int i = 0; i < 16; ++i) { const float p = __builtin_amdgcn_exp2f(S[tl][i] - mx); S[tl][i] = p; sum += p; }
  sum += __shfl_xor(sum, 32);
  sum += __builtin_amdgcn_exp2f(sk - mx);
  const float rs = 1.0f / sum;
  f32x16 O[2];
#pragma unroll
  for (int dt = 0; dt < 2; ++dt)
#pragma unroll
    for (int i = 0; i < 16; ++i) O[dt][i] = 0.f;
  const int i16 = lane & 15, q4 = i16 >> 2, p4 = i16 & 3, g16 = (lane >> 4) & 1;
  LAS unsigned char* vb = lds + (32 * sub + 4 * h + q4) * 128 + (16 * g16 + 4 * p4) * 2;
#pragma unroll
  for (int tl = 0; tl < 5; ++tl)
#pragma unroll
    for (int s = 0; s < 2; ++s) {
      const bf16x8 P = pack8(S[tl], s);
#pragma unroll
      for (int dt = 0; dt < 2; ++dt) {
        LAS unsigned char* p = vb + (32 * tl + 16 * s) * 128 + dt * 64;
        const s16x4 lo = tr_read(p), hi = tr_read(p + 8 * 128);
        const bf16x8 A2 = __builtin_shufflevector(lo, hi, 0, 1, 2, 3, 4, 5, 6, 7);
        O[dt] = MFMA32(A2, P, O[dt]);
      }
    }
  const size_t row = rowbase + t0 + r;
#pragma unroll
  for (int dt = 0; dt < 2; ++dt)
#pragma unroll
    for (int g4 = 0; g4 < 4; ++g4) {
      const int d = 32 * dt + 8 * g4 + 4 * h;
      const u32x2 gt = *(const u32x2*)(H + row * HP + C_AG + hq * 64 + d);
      const float o0 = O[dt][4 * g4 + 0] * rs * __uint_as_float(gt.x << 16), o1 = O[dt][4 * g4 + 1] * rs * __uint_as_float(gt.x & 0xffff0000u);
      const float o2 = O[dt][4 * g4 + 2] * rs * __uint_as_float(gt.y << 16), o3 = O[dt][4 * g4 + 3] * rs * __uint_as_float(gt.y & 0xffff0000u);
      u32x2 w; w.x = cvt_pk_bf16(o0, o1); w.y = cvt_pk_bf16(o2, o3);
      *(u32x2*)(MIX + row * DM + hq * 64 + d) = w;
    }
  __syncthreads();
}

constexpr int LC = 960, L_SCR = 32 * LC * 4, L_CNT = L_SCR + 8 * 4608, L_TAU = L_CNT + 128, L_WL = L_TAU + 128, L_UNIT = L_WL + 512, L_BAR = L_UNIT + 64;
static_assert(L_BAR + 64 <= LDS_BYTES, "LDS map");
__device__ __forceinline__ void radix_pass2(LAS unsigned* L, unsigned n, LAS unsigned* hist, int shift_hi, unsigned& prefix, unsigned& mask, unsigned& kk, unsigned& kept, int lane) {
#pragma unroll 1
  for (int p = 0; p < 2; ++p) {
    const int shift = shift_hi - 8 * p;
    *(LAS u32x4*)(hist + 4 * lane) = (u32x4){0u, 0u, 0u, 0u};
    LDSWAIT();
    for (unsigned i = 4u * lane; i < n; i += 256u) {
      const u32x4 e4 = *(LAS u32x4*)(L + i);
#pragma unroll
      for (int j = 0; j < 4; ++j) { const unsigned e = e4[j]; if (i + j < n && (e & mask) == prefix) __hip_atomic_fetch_add(hist + ((e >> shift) & 255u), 1u, __ATOMIC_RELAXED, __HIP_MEMORY_SCOPE_WORKGROUP); }
    }
    LDSWAIT();
    const u32x4 hb = *(LAS u32x4*)(hist + 4 * lane);
    const unsigned s4 = hb.x + hb.y + hb.z + hb.w;
    unsigned incl = s4;
#pragma unroll
    for (int o = 1; o < 64; o <<= 1) { const unsigned t = __shfl_down(incl, o); if (lane + o < 64) incl += t; }
    unsigned run = incl - s4;
    bool found = false; unsigned Bl = 0u, abl = 0u, bcl = 0u;
#pragma unroll
    for (int bb = 3; bb >= 0; --bb) { const unsigned c = hb[bb]; if (!found && run < kk && run + c >= kk) { found = true; Bl = 4u * lane + bb; abl = run; bcl = c; } run += c; }
    const unsigned long long fm = __ballot(found);
    const int src = __ffsll((long long)fm) - 1;
    const unsigned B = (unsigned)__builtin_amdgcn_readlane((int)Bl, src), above = (unsigned)__builtin_amdgcn_readlane((int)abl, src), bc = (unsigned)__builtin_amdgcn_readlane((int)bcl, src);
    prefix |= B << shift; mask |= 255u << shift;
    kept = (256u - kk) + above + bc;
    kk -= above;
  }
}
__device__ __forceinline__ unsigned compact_ge(LAS unsigned* L, unsigned n, unsigned prefix, int lane) {
  unsigned off = 0u;
  for (unsigned base = 0; base < n; base += 64) {
    const unsigned i = base + lane; const unsigned e = (i < n) ? L[i] : 0u; const bool keep = (i < n) && (e >= prefix);
    const unsigned long long km = __ballot(keep);
    const unsigned pos = off + (unsigned)__popcll(km & ((1ull << lane) - 1ull));
    if (keep) L[pos] = e;
    off += (unsigned)__popcll(km);
  }
  LDSWAIT();
  return off;
}
__device__ __forceinline__ void select_compact(LAS unsigned* L, unsigned n, LAS unsigned* hist, unsigned limit, LAS unsigned* cntp, LAS float* taup, int lane) {
  unsigned prefix = 0u, mask = 0u, kk = 256u, kept = n;
  radix_pass2(L, n, hist, 24, prefix, mask, kk, kept, lane);
  unsigned n1 = compact_ge(L, n, prefix, lane);
  if (n1 > limit) {
    radix_pass2(L, n1, hist, 8, prefix, mask, kk, kept, lane);
    n1 = compact_ge(L, n1, prefix, lane);
  }
  if (lane == 0) {
    const unsigned p19 = prefix & 0xffffe000u;
    const unsigned fb = (p19 & 0x80000000u) ? (p19 ^ 0x80000000u) : ~p19;
    *cntp = n1; *taup = p19 ? __uint_as_float(fb) : -INFINITY;
  }
  LDSWAIT();
}

__device__ __forceinline__ void indexer_unit(LAS unsigned char* lds, int u, const bf16_t* H, const float* IW, unsigned short* SEL, int* NSEL) {
  const int tid = threadIdx.x, lane = tid & 63, wid = __builtin_amdgcn_readfirstlane(tid >> 6), r = lane & 31, h = lane >> 5;
  const int b = u & 1, qblk = 255 - (u >> 1);
  LAS unsigned* lists = (LAS unsigned*)lds;
  LAS float* scr = (LAS float*)(lds + L_SCR + wid * 4608);
  LAS unsigned* hist = (LAS unsigned*)(lds + L_SCR + wid * 4608);
  LAS unsigned* cnt = (LAS unsigned*)(lds + L_CNT);
  LAS float* tau = (LAS float*)(lds + L_TAU);
  LAS float* wl = (LAS float*)(lds + L_WL);
  const int q0 = qblk * 32; const size_t rowbase = (size_t)b * SEQ;
  if (tid < 32) { cnt[tid] = 0u; tau[tid] = -INFINITY; *(LAS f32x4*)(wl + tid * 4) = *(const f32x4*)(IW + (rowbase + q0 + tid) * 4); }
  bf16x8 Aq[4][4];
#pragma unroll
  for (int rt = 0; rt < 4; ++rt)
#pragma unroll
    for (int ks = 0; ks < 4; ++ks) Aq[rt][ks] = ldg16(H + (rowbase + q0 + 8 * rt + (r >> 2)) * HP + C_IQ + (r & 3) * 64 + 16 * ks + 8 * h);
  __syncthreads();
  const int nch = (q0 + 32 + 255) >> 8;
  float mytau = -INFINITY; const int myq = lane & 31, mykh = lane >> 5;
  bf16x8 Bk[4];
#pragma unroll
  for (int ks = 0; ks < 4; ++ks) Bk[ks] = ldg16(H + (rowbase + wid * 32 + r) * HP + C_IK + 16 * ks + 8 * h);
#define IDX_SCORE(c_) do { const int kt0_ = (c_) * 256 + wid * 32; \
    if (kt0_ <= q0 + 31) { \
      _Pragma("unroll") for (int rt = 0; rt < 4; ++rt) { \
        f32x16 acc; \
        _Pragma("unroll") for (int i = 0; i < 16; ++i) acc[i] = 0.f; \
        _Pragma("unroll") for (int ks = 0; ks < 4; ++ks) acc = MFMA32(Aq[rt][ks], Bk[ks], acc); \
        _Pragma("unroll") for (int g = 0; g < 4; ++g) { \
          const int ql = 8 * rt + 2 * g + h; \
          const f32x4 w = *(LAS f32x4*)(wl + ql * 4); \
          float s = w[0] * relu1(acc[4 * g]); \
          s = __builtin_fmaf(w[1], relu1(acc[4 * g + 1]), s); s = __builtin_fmaf(w[2], relu1(acc[4 * g + 2]), s); s = __builtin_fmaf(w[3], relu1(acc[4 * g + 3]), s); \
          scr[ql * 36 + r] = s; } } } } while (0)
  IDX_SCORE(0);
  for (int c = 0; c < nch; ++c) {
    const int kt0 = c * 256 + wid * 32;
    if (c + 1 < nch) {
#pragma unroll
      for (int ks = 0; ks < 4; ++ks) Bk[ks] = ldg16(H + (rowbase + kt0 + 256 + r) * HP + C_IK + 16 * ks + 8 * h);
    }
    if (kt0 <= q0 + 31) {
      LDSWAIT();
      f32x4 e[4];
#pragma unroll
      for (int i = 0; i < 4; ++i) e[i] = *(LAS f32x4*)(scr + myq * 36 + mykh * 16 + 4 * i);
      unsigned m = 0u;
#pragma unroll
      for (int i = 0; i < 4; ++i)
#pragma unroll
        for (int j = 0; j < 4; ++j) asm volatile("v_cmp_ge_f32 vcc, %1, %2\n\tv_addc_co_u32 %0, vcc, %0, %0, vcc" : "+v"(m) : "v"(e[i][j]), "v"(mytau) : "vcc");
      int nv = q0 + myq - (kt0 + 16 * mykh) + 1; nv = nv < 0 ? 0 : (nv > 16 ? 16 : nv);
      m &= (0xffffu << (16 - nv)) & 0xffffu;
      const unsigned np = (unsigned)__popc(m);
      unsigned pos = 0u;
      if (np) pos = __hip_atomic_fetch_add(cnt + myq, np, __ATOMIC_RELAXED, __HIP_MEMORY_SCOPE_WORKGROUP);
      LAS unsigned* lp = lists + myq * LC;
      while (m) {
        const int bb = 31 - __clz((int)m); m ^= 1u << bb;
        const int j = 15 - bb;
        const float sv = scr[myq * 36 + mykh * 16 + j];
        unsigned ub = __float_as_uint(sv); ub = (ub & 0x7fffffffu) ? ub : 0u;
        const unsigned ord = ub ^ ((unsigned)((int)ub >> 31) | 0x80000000u);
        lp[pos] = (ord & 0xffffe000u) | (unsigned)(8191 - (kt0 + 16 * mykh + j)); ++pos;
      }
    }
    __syncthreads();
    const bool last = (c == nch - 1);
    for (int qq = wid; qq < 32; qq += 8) {
      const unsigned n = cnt[qq];
      if (last ? (n > 256u) : (n > (unsigned)(LC - 256))) select_compact(lists + qq * LC, n, hist, last ? 256u : 384u, cnt + qq, tau + qq, lane);
    }
    if (!last) IDX_SCORE(c + 1);
    __syncthreads();
    mytau = tau[myq];
  }
#undef IDX_SCORE
  for (int qq = wid; qq < 32; qq += 8) {
    const unsigned n = cnt[qq]; const size_t row = rowbase + q0 + qq;
#pragma unroll
    for (int i = 0; i < 4; ++i) { const int sl = lane + 64 * i; SEL[row * 256 + sl] = (unsigned)sl < n ? (unsigned short)(8191u - (lists[qq * LC + sl] & 0x1fffu)) : (unsigned short)0; }
    if (lane == 0) NSEL[row] = (int)n;
  }
  __syncthreads();
}

__device__ __forceinline__ void sparse_attn_phase(LAS unsigned char* lds, const bf16_t* H, const unsigned short* SEL, const int* NSEL, bf16_t* MIX) {
  const int tid = threadIdx.x, lane = tid & 63, wid = __builtin_amdgcn_readfirstlane(tid >> 6), r = lane & 31, h = lane >> 5;
  const int gw = blockIdx.x * NWAVES + wid, NGW = gridDim.x * NWAVES;
  LAS unsigned char* vbuf = lds + wid * 16384;
  LAS unsigned char* selb = lds + 131072 + wid * 1024;
  const int i16 = lane & 15, q4 = i16 >> 2, p4 = i16 & 3, g16 = (lane >> 4) & 1;
  const unsigned troff = (4 * h + q4) * 128 + (16 * g16 + 4 * p4) * 2;
  const int hk_off = C_BK + 8 * h, hv_off = C_BV + (lane & 7) * 8;
#define SP_LOAD(A, V, tl, qi) do { \
    const int kidx_ = (int)*(LAS unsigned short*)(selb + (qi) * 512 + 2 * (32 * (tl) + r)); \
    _Pragma("unroll") for (int ks = 0; ks < 4; ++ks) A[ks] = ldg16(H + ((rowbase + kidx_) * HP + hk_off + 16 * ks)); \
    _Pragma("unroll") for (int i = 0; i < 4; ++i) { const int kiv_ = (int)*(LAS unsigned short*)(selb + (qi) * 512 + 2 * (32 * (tl) + (lane >> 3) + 8 * i)); \
      V[i] = *(const u32x4*)(H + ((rowbase + kiv_) * HP + hv_off)); } } while (0)
#define SP_COMPUTE(A, V, tl, qi, Bq, O, mx, sum, n) do { \
    LAS unsigned char* vb = vbuf + (qi) * 8192 + ((tl) & 1) * 4096; \
    f32x16 S; \
    _Pragma("unroll") for (int i = 0; i < 16; ++i) S[i] = 0.f; \
    _Pragma("unroll") for (int ks = 0; ks < 4; ++ks) S = MFMA32(A[ks], Bq[ks], S); \
    _Pragma("unroll") for (int i = 0; i < 4; ++i) *(LAS u32x4*)(vb + ((lane >> 3) + 8 * i) * 128 + (lane & 7) * 16) = V[i]; \
    float tm = -INFINITY; \
    _Pragma("unroll") for (int i = 0; i < 16; ++i) { const bool valid = 32 * (tl) + crow(i, h) < n; S[i] = valid ? S[i] : -INFINITY; tm = fmaxf(tm, S[i]); } \
    tm = fmaxf(tm, __shfl_xor(tm, 32)); \
    const float mn = fmaxf(mx, tm), corr = exp2f(mx - mn); \
    mx = mn; \
    float ps = 0.f; \
    _Pragma("unroll") for (int i = 0; i < 16; ++i) { const float p = exp2f(S[i] - mn); S[i] = p; ps += p; } \
    sum = sum * corr + ps; \
    _Pragma("unroll") for (int dt = 0; dt < 2; ++dt) _Pragma("unroll") for (int i = 0; i < 16; ++i) O[dt][i] *= corr; \
    LDSWAIT(); \
    _Pragma("unroll") for (int s = 0; s < 2; ++s) { \
      const bf16x8 P = pack8(S, s); \
      _Pragma("unroll") for (int dt = 0; dt < 2; ++dt) { \
        LAS unsigned char* p = vb + troff + (16 * s) * 128 + dt * 64; \
        const s16x4 lo = tr_read(p), hi = tr_read(p + 8 * 128); \
        const bf16x8 A2 = __builtin_shufflevector(lo, hi, 0, 1, 2, 3, 4, 5, 6, 7); \
        O[dt] = MFMA32(A2, P, O[dt]); } } } while (0)
#define SP_STORE(row, O, sum) do { \
    const float tot_ = sum + __shfl_xor(sum, 32); const float rs = 1.0f / tot_; \
    if (r < 8) { \
      _Pragma("unroll") for (int dt = 0; dt < 2; ++dt) _Pragma("unroll") for (int g4 = 0; g4 < 4; ++g4) { \
          const int d = 32 * dt + 8 * g4 + 4 * h; \
          const u32x2 gt = *(const u32x2*)(H + (size_t)(row) * HP + C_BG + r * 64 + d); \
          const float o0 = O[dt][4 * g4 + 0] * rs * __uint_as_float(gt.x << 16), o1 = O[dt][4 * g4 + 1] * rs * __uint_as_float(gt.x & 0xffff0000u); \
          const float o2 = O[dt][4 * g4 + 2] * rs * __uint_as_float(gt.y << 16), o3 = O[dt][4 * g4 + 3] * rs * __uint_as_float(gt.y & 0xffff0000u); \
          u32x2 w; w.x = cvt_pk_bf16(o0, o1); w.y = cvt_pk_bf16(o2, o3); \
          *(u32x2*)(MIX + (size_t)(row) * DM + 512 + r * 64 + d) = w; } } } while (0)
  for (int pr = gw; pr < M / 2; pr += NGW) {
    const int row0 = 2 * pr, row1 = row0 + 1;
    const int rowbase = (row0 >> 13) * SEQ;
    const int n0 = __builtin_amdgcn_readfirstlane(NSEL[row0]), n1 = __builtin_amdgcn_readfirstlane(NSEL[row1]);
    *(LAS u32x2*)(selb + lane * 8) = *(const u32x2*)(SEL + (size_t)row0 * 256 + lane * 4);
    *(LAS u32x2*)(selb + 512 + lane * 8) = *(const u32x2*)(SEL + (size_t)row1 * 256 + lane * 4);
    bf16x8 Bq0[4], Bq1[4];
#pragma unroll
    for (int ks = 0; ks < 4; ++ks) {
      bf16x8 v0 = ldg16(H + (size_t)row0 * HP + C_BQ + (r & 7) * 64 + 16 * ks + 8 * h), v1 = ldg16(H + (size_t)row1 * HP + C_BQ + (r & 7) * 64 + 16 * ks + 8 * h);
      if (r >= 8) { v0 = (bf16x8){0, 0, 0, 0, 0, 0, 0, 0}; v1 = v0; }
      Bq0[ks] = v0; Bq1[ks] = v1; }
    f32x16 O0[2], O1[2];
#pragma unroll
    for (int dt = 0; dt < 2; ++dt)
#pragma unroll
      for (int i = 0; i < 16; ++i) { O0[dt][i] = 0.f; O1[dt][i] = 0.f; }
    float mx0 = -INFINITY, sum0 = 0.f, mx1 = -INFINITY, sum1 = 0.f;
    LDSWAIT();
    bf16x8 A0[4], A1[4]; u32x4 V0[4], V1[4];
    SP_LOAD(A0, V0, 0, 0);
#pragma unroll 1
    for (int tl = 0; tl < 8; ++tl) {
      SP_LOAD(A1, V1, tl, 1);
      SP_COMPUTE(A0, V0, tl, 0, Bq0, O0, mx0, sum0, n0);
      const int tn = tl < 7 ? tl + 1 : 7;
      SP_LOAD(A0, V0, tn, 0);
      SP_COMPUTE(A1, V1, tl, 1, Bq1, O1, mx1, sum1, n1);
    }
    SP_STORE(row0, O0, sum0);
    SP_STORE(row1, O1, sum1);
    LDSWAIT();
  }
#undef SP_LOAD
#undef SP_COMPUTE
#undef SP_STORE
}

__device__ __forceinline__ float wave_sum(float v) {
#pragma unroll
  for (int o = 1; o < 64; o <<= 1) v += __shfl_xor(v, o);
  return v;
}
__device__ __forceinline__ void ln_phase(const float* Y, const float* g, const float* bta, float* out) {
  const int tid = threadIdx.x, lane = tid & 63, wid = tid >> 6;
  const int gw = blockIdx.x * NWAVES + wid, NGW = gridDim.x * NWAVES;
  f32x4 gv[4], bv[4];
#pragma unroll
  for (int j = 0; j < 4; ++j) { gv[j] = *(const f32x4*)(g + 4 * lane + 256 * j); bv[j] = *(const f32x4*)(bta + 4 * lane + 256 * j); }
  for (int row = gw; row < M; row += NGW) {
    const f32x4* yr = (const f32x4*)(Y + (size_t)row * DM) + lane;
    f32x4 v[4]; float s = 0.f;
#pragma unroll
    for (int j = 0; j < 4; ++j) { v[j] = yr[64 * j]; s += (v[j][0] + v[j][1]) + (v[j][2] + v[j][3]); }
    const float mean = wave_sum(s) * (1.f / DM); float s2 = 0.f;
#pragma unroll
    for (int j = 0; j < 4; ++j) { v[j] = v[j] - mean; s2 += (v[j][0] * v[j][0] + v[j][1] * v[j][1]) + (v[j][2] * v[j][2] + v[j][3] * v[j][3]); }
    const float rstd = 1.f / sqrtf(wave_sum(s2) * (1.f / DM) + LN_EPS);
    f32x4* o = (f32x4*)(out + (size_t)row * DM) + lane;
#pragma unroll
    for (int j = 0; j < 4; ++j) o[64 * j] = v[j] * rstd * gv[j] + bv[j];
  }
}

#define XB_TMO      128
#define XB_XCNT(j)  (256  + 64 * (j))
#define XB_XSUB(j)  (1280 + 64 * (j))
#define XB_XGEN(j)  (2304 + 64 * (j))
#define XB_TOP      3328
#define XB_TOPGEN   3392
#define XCD_BAR_WORDS 3456
#define XB_SPIN_CAP (1u << 18)

__device__ __forceinline__ unsigned xb_ld(unsigned* p)              { return __hip_atomic_load(p, __ATOMIC_RELAXED, __HIP_MEMORY_SCOPE_AGENT); }
__device__ __forceinline__ unsigned xb_add(unsigned* p, unsigned v) { return __hip_atomic_fetch_add(p, v, __ATOMIC_RELAXED, __HIP_MEMORY_SCOPE_AGENT); }
__device__ __forceinline__ unsigned xb_xcc_id() { return (unsigned)__builtin_amdgcn_s_getreg((3 << 11) | 20) & 0xFu; }
#define XB_SPIN(cond, bar) do { unsigned _sp = 0; while (cond) { __builtin_amdgcn_s_sleep(1); \
    if ((++_sp & 255u) == 0u) { if (xb_ld(&(bar)[XB_TMO])) break; if (_sp > XB_SPIN_CAP) { atomicAdd(&(bar)[XB_TMO], 1u); break; } } } } while (0)

struct XcdBarrier {
    unsigned* bar; unsigned x;
    volatile LAS unsigned* st;
};

__device__ __forceinline__ XcdBarrier xcd_barrier_post(unsigned* bar, volatile LAS unsigned* st) {
    XcdBarrier b; b.bar = bar; b.x = xb_xcc_id(); b.st = st;
    if (threadIdx.x == 0) (void)xb_add(&bar[XB_XCNT(b.x)], 1u);
    return b;
}
__device__ __forceinline__ void xcd_barrier_complete(unsigned* bar, unsigned x, unsigned& nloc, unsigned& nx) {
    const unsigned G = gridDim.x * gridDim.y * gridDim.z;
    unsigned sum, cnt, mine, sp = 0u;
    for (;;) {
        sum = 0u; cnt = 0u; mine = 0u;
#pragma unroll
        for (unsigned j = 0; j < 16; ++j) { const unsigned c = xb_ld(&bar[XB_XCNT(j)]); sum += c; cnt += (c > 0u) ? 1u : 0u; mine = (j == x) ? c : mine; }
        if (sum == G) break;
        __builtin_amdgcn_s_sleep(1);
        if ((++sp & 255u) == 0u) { if (xb_ld(&bar[XB_TMO])) break; if (sp > XB_SPIN_CAP) { atomicAdd(&bar[XB_TMO], 1u); break; } }
    }
    nloc = mine > 0u ? mine : 1u; nx = cnt > 0u ? cnt : 1u;
}

__device__ __forceinline__ void xcd_barrier(const XcdBarrier& b) {
    asm volatile("s_waitcnt vmcnt(0)" ::: "memory");
    __syncthreads();
    if (threadIdx.x == 0) {
        unsigned* bar = b.bar;
        __builtin_amdgcn_s_waitcnt(0);
        unsigned nloc = b.st[0], nx = b.st[1];
        if (nloc == 0u) { xcd_barrier_complete(bar, b.x, nloc, nx); b.st[0] = nloc; b.st[1] = nx; }
        const unsigned old = xb_add(&bar[XB_XSUB(b.x)], 1u);
        const unsigned gen = old / nloc;
        if (old + 1u == (gen + 1u) * nloc) {
            __builtin_amdgcn_fence(__ATOMIC_RELEASE, "agent");
            asm volatile("s_waitcnt vmcnt(0)" ::: "memory");
            const unsigned og = xb_add(&bar[XB_TOP], 1u);
            const unsigned tg = og / nx;
            if (og + 1u == (tg + 1u) * nx) xb_add(&bar[XB_TOPGEN], 1u);
            else XB_SPIN(xb_ld(&bar[XB_TOPGEN]) == tg, bar);
            __builtin_amdgcn_fence(__ATOMIC_ACQUIRE, "agent");
            xb_add(&bar[XB_XGEN(b.x)], 1u);
            asm volatile("s_waitcnt vmcnt(0)" ::: "memory");
        } else {
            XB_SPIN(xb_ld(&bar[XB_XGEN(b.x)]) == gen, bar);
            __builtin_amdgcn_fence(__ATOMIC_ACQUIRE, "agent");
            asm volatile("s_waitcnt vmcnt(0)" ::: "memory");
        }
    }
    __syncthreads();
}

#ifndef PHMASK
#define PHMASK 255
#endif
#ifndef REPMASK
#define REPMASK 0
#endif
__global__ void __launch_bounds__(NTHREADS, 2) hybrid_fwd(Args a) {
  extern __shared__ __attribute__((aligned(16))) unsigned char lds_raw[];
  LAS unsigned char* lds = (LAS unsigned char*)lds_raw;
  cg::grid_group grid = cg::this_grid();
  const int tid = threadIdx.x;
  if (a.ws == nullptr) grid.sync();
  bf16_t* BTIN = (bf16_t*)(a.ws + WS_BTIN); bf16_t* BTOUT = (bf16_t*)(a.ws + WS_BTOUT);
  bf16_t* XN = (bf16_t*)(a.ws + WS_XN); bf16_t* H = (bf16_t*)(a.ws + WS_H); bf16_t* MIX = (bf16_t*)(a.ws + WS_MIX);
  float* IW = (float*)(a.ws + WS_IW); float* YPRE = (float*)(a.ws + WS_YPRE);
  int* NSEL = (int*)(a.ws + WS_NSEL); unsigned short* SEL = (unsigned short*)(a.ws + WS_SEL);
  unsigned* ctl = (unsigned*)(a.ws + WS_CTL);
  volatile LAS unsigned* bst = (volatile LAS unsigned*)(lds + L_BAR);
  if (tid < 2) bst[tid] = 0u;
  __syncthreads();
  const XcdBarrier bar = xcd_barrier_post(ctl + 1024, bst);
  if (PHMASK & 1) for (int rep = 0; rep < ((REPMASK & 1) ? 2 : 1); ++rep) p0_prologue(a, lds);
  xcd_barrier(bar);
  if (PHMASK & 2) {
    pg8::Gemm g{XN, BTIN, M, NPAD, DM}; pg8::StaticOrder S; S.init(M, NPAD, (int)gridDim.x, (int)blockIdx.x);
    EpiInProj E{H, IW, a.b_in, (const f32x2*)(a.ws + WS_CS)};
    pg8::gemm_phase<EpiInProj, pg8::StaticOrder, true, true>(lds, g, S, E);
  }
  if (REPMASK & 2) {
    pg8::Gemm g{XN, BTIN, M, NPAD, DM}; pg8::StaticOrder S; S.init(M, NPAD, (int)gridDim.x, (int)blockIdx.x);
    EpiInProj E{H, IW, a.b_in, (const f32x2*)(a.ws + WS_CS)};
    pg8::gemm_phase<EpiInProj, pg8::StaticOrder, true, true>(lds, g, S, E);
  }
  xcd_barrier(bar);
  if (PHMASK & 4) {
    LAS int* us = (LAS int*)(lds + L_UNIT);
    if (PHMASK & 64) for (int rep = 0; rep < ((REPMASK & 64) ? 2 : 1); ++rep) for (;;) {
      if (tid == 0) *us = (int)__hip_atomic_fetch_add(ctl + 128 * rep, 1u, __ATOMIC_RELAXED, __HIP_MEMORY_SCOPE_AGENT);
      __syncthreads();
      const int u = *us;
      __syncthreads();
      if (u >= 512) break;
      indexer_unit(lds, u, H, IW, SEL, NSEL);
    }
    if (PHMASK & 128) for (int rep = 0; rep < ((REPMASK & 128) ? 2 : 1); ++rep) for (;;) {
      if (tid == 0) *us = (int)__hip_atomic_fetch_add(ctl + 64 + 128 * rep, 1u, __ATOMIC_RELAXED, __HIP_MEMORY_SCOPE_AGENT);
      __syncthreads();
      const int u = *us;
      __syncthreads();
      if (u >= 512) break;
      swa_unit(lds, u, H, a.sinks, MIX);
    }
  }
  xcd_barrier(bar);
  if (PHMASK & 8) for (int rep = 0; rep < ((REPMASK & 8) ? 2 : 1); ++rep) sparse_attn_phase(lds, H, SEL, NSEL, MIX);
  xcd_barrier(bar);
  if (PHMASK & 16) for (int rep = 0; rep < ((REPMASK & 16) ? 2 : 1); ++rep) {
    pg8::Gemm g{MIX, BTOUT, M, DM, DM}; pg8::StaticOrder S; S.init(M, DM, (int)gridDim.x, (int)blockIdx.x);
    EpiOutProj E{YPRE, a.b_out, a.x};
    pg8::gemm_phase<EpiOutProj, pg8::StaticOrder, true, true>(lds, g, S, E);
  }
  xcd_barrier(bar);
  if (PHMASK & 32) for (int rep = 0; rep < ((REPMASK & 32) ? 2 : 1); ++rep) ln_phase(YPRE, a.ln_g, a.ln_b, a.out);
}

extern "C" void kernel_launch(void* const* d_in, const int* in_sizes, int n_in, void* d_out, int out_size, void* d_ws, size_t ws_size, hipStream_t stream) {
  static int grid = 0;
  if (grid == 0) {
    if (n_in != 9 || ws_size < WS_END) { fprintf(stderr, "kernel_launch: unexpected inputs (n_in %d, ws %zu)\n", n_in, ws_size); grid = -1; return; }
    int dev = 0, cus = 0, per_cu = 0;
    (void)hipGetDevice(&dev); (void)hipDeviceGetAttribute(&cus, hipDeviceAttributeMultiprocessorCount, dev);
    if (hipFuncSetAttribute((const void*)hybrid_fwd, hipFuncAttributeMaxDynamicSharedMemorySize, LDS_BYTES) != hipSuccess) { fprintf(stderr, "kernel_launch: hipFuncSetAttribute failed\n"); grid = -1; return; }
    (void)hipOccupancyMaxActiveBlocksPerMultiprocessor(&per_cu, (const void*)hybrid_fwd, NTHREADS, LDS_BYTES);
    if (per_cu < 1) { fprintf(stderr, "kernel_launch: occupancy query says %d blocks per CU\n", per_cu); per_cu = 1; }
    (void)hipGetLastError();
    grid = cus;
  }
  if (grid < 0) return;
  (void)hipMemsetAsync((char*)d_ws + WS_CTL, 0, 32768, stream);
  Args a{};
  a.x = (const float*)d_in[0]; a.pos = (const int*)d_in[1]; a.w_in = (const float*)d_in[2]; a.b_in = (const float*)d_in[3]; a.sinks = (const float*)d_in[4];
  a.w_out = (const float*)d_in[5]; a.b_out = (const float*)d_in[6]; a.ln_g = (const float*)d_in[7]; a.ln_b = (const float*)d_in[8];
  a.out = (float*)d_out; a.ws = (unsigned char*)d_ws;
  void* args[] = {&a};
  hipError_t e = hipLaunchCooperativeKernel((const void*)hybrid_fwd, dim3(grid), dim3(NTHREADS), args, LDS_BYTES, stream);
  if (e != hipSuccess) fprintf(stderr, "kernel_launch: cooperative launch failed: %s (grid %d)\n", hipGetErrorString(e), grid);
}
```

```cpp
#include <hip/hip_runtime.h>
#include <hip/hip_cooperative_groups.h>
#include <cstdio>
#include <cstdint>
namespace cg = cooperative_groups;
namespace pg8 {
#define PG8_LAS __attribute__((address_space(3)))
typedef unsigned short bf16_t;
typedef short bf16x8 __attribute__((ext_vector_type(8)));
typedef float f32x4 __attribute__((ext_vector_type(4)));
typedef unsigned u32x4 __attribute__((ext_vector_type(4)));
constexpr int BM = 256, BK = 64, HALF = 128, HTB = HALF * BK * 2  , STAGE_BYTES = 8 * HTB, NXCD = 8, WGM = 8;

__host__ __device__ __forceinline__ int lds_byte(int r, int c) { const int st = (r >> 4) * 2 + (c >> 5), rr = r & 15, cc = c & 31, ob = rr * 64 + cc * 2; return st * 1024 + (ob ^ (((ob >> 9) & 1) << 5)); }
__host__ __device__ __forceinline__ void stage_rc(int b, int& R, int& C) { const int st = b / 1024, sb = b % 1024, swz = sb ^ (((sb >> 9) & 1) << 5); R = (st >> 1) * 16 + swz / 64; C = (st & 1) * 32 + (swz % 64) / 2; }
__host__ __device__ __forceinline__ int perm32(int rho) { const int n = rho >> 4, i = rho & 15; return 8 * (i >> 2) + 4 * n + (i & 3); }

struct Unit { int pm, pn; };
struct Gemm { const bf16_t* A; const bf16_t* Bt; int M, N, K; };

struct StaticOrder {
    int nM, nN, nwg, G, c;
    __host__ __device__ void init(int M, int N, int G_, int c_) { nM = M / BM; nN = N / BM; nwg = nM * nN; G = G_; c = c_; }
    __host__ __device__ bool next(int i, Unit& u) const {
        const long L = (long)i * G + c; if (L >= nwg) return false;
        int wgid = (int)L; { const int q = nwg / NXCD, r = nwg % NXCD, xcd = wgid % NXCD, off = wgid / NXCD; wgid = (xcd < r ? xcd * (q + 1) : r * (q + 1) + (xcd - r) * q) + off; }
        const int nig = WGM * nN, gid = wgid / nig, fm = gid * WGM, gsz = (nM - fm) < WGM ? (nM - fm) : WGM;
        u.pm = fm + ((wgid % nig) % gsz); u.pn = (wgid % nig) / gsz; return true;
    }
    __device__ __forceinline__ void a_ready(const Unit&) const {}
    __device__ __forceinline__ void done(const Unit&) const {}
};

__device__ __forceinline__ unsigned cvt_pk_bf16(float lo, float hi) { unsigned r; asm volatile("v_cvt_pk_bf16_f32 %0, %1, %2" : "=v"(r) : "v"(lo), "v"(hi)); return r; }
template <class Epi, class Sched, bool ALIGN_EPI = false, bool SP2 = false>
__device__ __forceinline__ void gemm_phase(PG8_LAS unsigned char* lds, const Gemm g, const Sched& S, const Epi& E) {
    const int tid = threadIdx.x, wid = __builtin_amdgcn_readfirstlane(tid >> 6), lane = tid & 63, wr = wid >> 2, wc = wid & 3, fr = lane & 15, fq = lane >> 4;
    const int K = g.K, nt = K / BK;
    unsigned voffA[2], voffB[2];
#pragma unroll
    for (int i = 0; i < 2; ++i) { int R, C; stage_rc(tid * 16 + i * 8192, R, C); const int Rb = Epi::PERM ? ((R & ~31) + perm32(R & 31)) : R;
        voffA[i] = (unsigned)(R * K + C) * 2u; voffB[i] = (unsigned)(Rb * K + C) * 2u; }
    const size_t kstep = (size_t)(BK * 2);
    const size_t hstep = (size_t)HALF * K * 2;
    const size_t tstep = 2 * hstep;
    const unsigned ldsw = (unsigned)wid * 1024u;
    const int aoff = lds_byte(wr * 64 + fr, fq * 8), boff = lds_byte(wc * 32 + fr, fq * 8);
#define PG8_SA(b, h) (((b) * 2 + (h)) * HTB)
#define PG8_SB(b, h) ((4 + (b) * 2 + (h)) * HTB)
#define PG8_STAGE(bufoff, gbase, voff) do { _Pragma("unroll") for (int _i = 0; _i < 2; ++_i) \
        __builtin_amdgcn_global_load_lds((const unsigned*)((const char*)(gbase) + (voff)[_i]), (PG8_LAS unsigned*)(lds + (bufoff) + ldsw + _i * 8192), 16, 0, 0); } while (0)
#define PG8_LDA(dst, b, h) do { _Pragma("unroll") for (int m = 0; m < 4; ++m) _Pragma("unroll") for (int k = 0; k < 2; ++k) dst[m][k] = *(const PG8_LAS bf16x8*)(lds + PG8_SA(b, h) + aoff + m * 2048 + k * 1024); } while (0)
#define PG8_LDB(dst, b, h) do { _Pragma("unroll") for (int n = 0; n < 2; ++n) _Pragma("unroll") for (int k = 0; k < 2; ++k) dst[n][k] = *(const PG8_LAS bf16x8*)(lds + PG8_SB(b, h) + boff + n * 2048 + k * 1024); } while (0)
#define PG8_MMA(ai, bj, At, Bt) do { __builtin_amdgcn_s_setprio(1); _Pragma("unroll") for (int m = 0; m < 4; ++m) _Pragma("unroll") for (int n = 0; n < 2; ++n) _Pragma("unroll") for (int k = 0; k < 2; ++k) \
        acc[ai][bj][m][n] = __builtin_amdgcn_mfma_f32_16x16x32_bf16(Bt[n][k], At[m][k], acc[ai][bj][m][n], 0, 0, 0); __builtin_amdgcn_s_setprio(0); } while (0)
#define PG8_WAIT_V(n) asm volatile("s_waitcnt vmcnt(" #n ")" ::: "memory")
#define PG8_WAIT_L(n) asm volatile("s_waitcnt lgkmcnt(" #n ")" ::: "memory")
#define PG8_BAR __builtin_amdgcn_s_barrier()
#define PG8_SCHED __builtin_amdgcn_sched_barrier(0)
    Unit cur, nxt; int ui = 0;
    if (!S.next(0, cur)) return;
    f32x4 acc[2][2][4][2];
#pragma unroll
    for (int a = 0; a < 2; ++a)
#pragma unroll
        for (int b = 0; b < 2; ++b)
#pragma unroll
            for (int m = 0; m < 4; ++m)
#pragma unroll
                for (int n = 0; n < 2; ++n) acc[a][b][m][n] = (f32x4){0.f, 0.f, 0.f, 0.f};
    bf16x8 At[4][2], B0[2][2], B1[2][2];
    const char* cA = (const char*)g.A + (size_t)cur.pm * tstep; const char* cB = (const char*)g.Bt + (size_t)cur.pn * tstep;
    S.a_ready(cur);
    if constexpr (SP2) {
        PG8_STAGE(PG8_SB(0, 0), cB, voffB); PG8_STAGE(PG8_SB(0, 1), cB + hstep, voffB); PG8_STAGE(PG8_SA(0, 0), cA, voffA); PG8_STAGE(PG8_SA(0, 1), cA + hstep, voffA);
        if (wr == 1) PG8_BAR;
        PG8_WAIT_V(2); PG8_BAR;
        PG8_STAGE(PG8_SB(1, 0), cB + kstep, voffB); PG8_STAGE(PG8_SA(1, 0), cA + kstep, voffA); PG8_STAGE(PG8_SB(1, 1), cB + hstep + kstep, voffB);
        PG8_WAIT_V(6); PG8_BAR;
    } else {
        PG8_STAGE(PG8_SB(0, 0), cB, voffB); PG8_STAGE(PG8_SA(0, 0), cA, voffA); PG8_STAGE(PG8_SB(0, 1), cB + hstep, voffB); PG8_STAGE(PG8_SA(0, 1), cA + hstep, voffA);
        if (wr == 1) PG8_BAR;
        PG8_WAIT_V(4); PG8_BAR;
        PG8_STAGE(PG8_SB(1, 0), cB + kstep, voffB); PG8_STAGE(PG8_SA(1, 0), cA + kstep, voffA); PG8_STAGE(PG8_SB(1, 1), cB + hstep + kstep, voffB);
        PG8_WAIT_V(6); PG8_BAR;
    }
    for (;;) {
        const bool has_next = S.next(ui + 1, nxt);
        const char* nA = has_next ? (const char*)g.A + (size_t)nxt.pm * tstep : cA; const char* nB = has_next ? (const char*)g.Bt + (size_t)nxt.pn * tstep : cB;
        for (int t = 0; t < nt; t += 2) {
            const bool last = (t == nt - 2);
            const char* a1 = cA + (size_t)(t + 1) * kstep;
            const char* a2 = last ? nA : cA + (size_t)(t + 2) * kstep; const char* b2 = last ? nB : cB + (size_t)(t + 2) * kstep;
            const char* a3 = a2 + kstep; const char* b3 = b2 + kstep;
            if (last && has_next) S.a_ready(nxt);
            if constexpr (SP2) {
            PG8_LDB(B0, 0, 0); PG8_LDB(B1, 0, 1); PG8_SCHED; PG8_LDA(At, 0, 0); PG8_STAGE(PG8_SA(1, 1), a1 + hstep, voffA);
            PG8_WAIT_V(8); PG8_WAIT_L(0); PG8_BAR; PG8_MMA(0, 0, At, B0); PG8_MMA(0, 1, At, B1); PG8_BAR; PG8_SCHED;
            PG8_LDA(At, 0, 1); PG8_STAGE(PG8_SB(0, 0), b2, voffB); PG8_STAGE(PG8_SB(0, 1), b2 + hstep, voffB); PG8_STAGE(PG8_SA(0, 0), a2, voffA);
            PG8_WAIT_V(8); PG8_WAIT_L(0); PG8_BAR; PG8_MMA(1, 0, At, B0); PG8_MMA(1, 1, At, B1); PG8_BAR; PG8_SCHED;
            PG8_LDB(B0, 1, 0); PG8_LDB(B1, 1, 1); PG8_SCHED; PG8_LDA(At, 1, 0); PG8_STAGE(PG8_SA(0, 1), a2 + hstep, voffA);
            PG8_WAIT_V(8); PG8_WAIT_L(0); PG8_BAR; PG8_MMA(0, 0, At, B0); PG8_MMA(0, 1, At, B1); PG8_BAR; PG8_SCHED;
            PG8_LDA(At, 1, 1); PG8_STAGE(PG8_SB(1, 0), b3, voffB); PG8_STAGE(PG8_SB(1, 1), b3 + hstep, voffB); PG8_STAGE(PG8_SA(1, 0), a3, voffA);
            PG8_WAIT_V(8); PG8_WAIT_L(0); PG8_BAR; PG8_MMA(1, 0, At, B0); PG8_MMA(1, 1, At, B1); PG8_BAR; PG8_SCHED;
            } else {
            PG8_LDB(B0, 0, 0); PG8_SCHED; PG8_LDA(At, 0, 0); PG8_STAGE(PG8_SA(1, 1), a1 + hstep, voffA);
            PG8_WAIT_L(8); PG8_BAR; PG8_WAIT_L(0); PG8_MMA(0, 0, At, B0); PG8_BAR; PG8_SCHED;
            PG8_LDB(B1, 0, 1); PG8_STAGE(PG8_SB(0, 0), b2, voffB);
            PG8_BAR; PG8_WAIT_L(0); PG8_MMA(0, 1, At, B1); PG8_BAR;
            PG8_LDA(At, 0, 1); PG8_STAGE(PG8_SA(0, 0), a2, voffA);
            PG8_BAR; PG8_WAIT_L(0); PG8_MMA(1, 0, At, B0); PG8_BAR; PG8_SCHED;
            PG8_STAGE(PG8_SB(0, 1), b2 + hstep, voffB);
            PG8_WAIT_V(6); PG8_BAR; PG8_MMA(1, 1, At, B1); PG8_BAR;
            PG8_LDB(B0, 1, 0); PG8_SCHED; PG8_LDA(At, 1, 0); PG8_STAGE(PG8_SA(0, 1), a2 + hstep, voffA);
            PG8_WAIT_L(8); PG8_BAR; PG8_WAIT_L(0); PG8_MMA(0, 0, At, B0); PG8_BAR; PG8_SCHED;
            PG8_LDB(B1, 1, 1); PG8_STAGE(PG8_SB(1, 0), b3, voffB);
            PG8_BAR; PG8_WAIT_L(0); PG8_MMA(0, 1, At, B1); PG8_BAR;
            PG8_LDA(At, 1, 1); PG8_STAGE(PG8_SA(1, 0), a3, voffA);
            PG8_BAR; PG8_WAIT_L(0); PG8_MMA(1, 0, At, B0); PG8_BAR; PG8_SCHED;
            PG8_STAGE(PG8_SB(1, 1), b3 + hstep, voffB);
            PG8_WAIT_V(6); PG8_BAR; PG8_MMA(1, 1, At, B1); PG8_BAR;
            }
        }
        if constexpr (ALIGN_EPI) { if (wr == 0) PG8_BAR; }
        if constexpr (!Epi::AFTER_DRAIN) { E(acc, cur, wr, wc, fr, fq); S.done(cur); }
        if (!has_next) break;
#pragma unroll
        for (int a = 0; a < 2; ++a)
#pragma unroll
            for (int b = 0; b < 2; ++b)
#pragma unroll
                for (int m = 0; m < 4; ++m)
#pragma unroll
                    for (int n = 0; n < 2; ++n) acc[a][b][m][n] = (f32x4){0.f, 0.f, 0.f, 0.f};
        cur = nxt; cA = nA; cB = nB; ++ui;
        if constexpr (ALIGN_EPI) { if (wr == 1) PG8_BAR; }
    }
    PG8_WAIT_V(0);
    if constexpr (!ALIGN_EPI) { if (wr == 0) PG8_BAR; }
    PG8_BAR;
    if constexpr (Epi::AFTER_DRAIN) { E.fused(acc, cur, wr, wc, fr, fq, lds, wid, lane); S.done(cur); }
#undef PG8_SA
#undef PG8_SB
#undef PG8_STAGE
#undef PG8_LDA
#undef PG8_LDB
#undef PG8_MMA
#undef PG8_WAIT_V
#undef PG8_WAIT_L
#undef PG8_BAR
#undef PG8_SCHED
}
}
#define LAS __attribute__((address_space(3)))
typedef unsigned short bf16_t;
typedef short bf16x8 __attribute__((ext_vector_type(8)));
typedef short s16x4 __attribute__((ext_vector_type(4)));
typedef float f32x4 __attribute__((ext_vector_type(4)));
typedef float f32x2 __attribute__((ext_vector_type(2)));
typedef float f32x16 __attribute__((ext_vector_type(16)));
typedef unsigned u32x4 __attribute__((ext_vector_type(4)));
typedef unsigned u32x2 __attribute__((ext_vector_type(2)));
using pg8::cvt_pk_bf16;

constexpr int SEQ = 8192, NB = 2, M = NB * SEQ, DM = 1024, NCOL = 2756, NPAD = 2816, HP = 2752;
constexpr int C_AQ = 0, C_AK = 512, C_AV = 640, C_AG = 768, C_BQ = 1280, C_BK = 1792, C_BV = 1856, C_BG = 1920, C_IQ = 2432, C_IK = 2688, C_IW = 2752;
constexpr float LOG2E = 1.4426950408889634f, QSCALE = 0.125f * LOG2E, LN_EPS = 1e-5f;
constexpr float ALPHA = 1.189207115002721f;
constexpr size_t MiB = 1u << 20;
constexpr size_t WS_CTL = 0, WS_BTIN = 2 * MiB, WS_BTOUT = 8 * MiB, WS_CS = 10 * MiB, WS_IW = 14 * MiB, WS_NSEL = 15 * MiB, WS_SEL = 16 * MiB,
                 WS_XN = 24 * MiB, WS_H = 56 * MiB, WS_MIX = 142 * MiB, WS_YPRE = 174 * MiB, WS_END = 238 * MiB;
constexpr int LDS_BYTES = 147456;
constexpr int NTHREADS = 512, NWAVES = 8;
#define MFMA32(a, b, c) __builtin_amdgcn_mfma_f32_32x32x16_bf16((a), (b), (c), 0, 0, 0)
#define LDSWAIT() asm volatile("s_waitcnt lgkmcnt(0)" ::: "memory")

__device__ __forceinline__ int crow(int i, int h) { return (i & 3) + 8 * (i >> 2) + 4 * h; }
__device__ __forceinline__ int swap45(int c) { return (c & ~48) | ((c & 16) << 1) | ((c & 32) >> 1); }
__device__ __forceinline__ float bf2f(unsigned short b) { return __uint_as_float((unsigned)b << 16); }
__device__ __forceinline__ bf16x8 ldg16(const bf16_t* p) { return *(const bf16x8*)p; }
__device__ __forceinline__ bf16x8 pack8(const f32x16& x, int s) {
  u32x4 p; p.x = cvt_pk_bf16(x[8 * s + 0], x[8 * s + 1]); p.y = cvt_pk_bf16(x[8 * s + 2], x[8 * s + 3]); p.z = cvt_pk_bf16(x[8 * s + 4], x[8 * s + 5]); p.w = cvt_pk_bf16(x[8 * s + 6], x[8 * s + 7]);
  return __builtin_bit_cast(bf16x8, p);
}
__device__ __forceinline__ float relu1(float x) { return __builtin_amdgcn_fmed3f(x, 0.f, __builtin_inff()); }
__device__ __forceinline__ s16x4 tr_read(LAS unsigned char* p) { return __builtin_amdgcn_ds_read_tr16_b64_v4i16((LAS s16x4*)p); }

struct Args { const float* x; const int* pos; const float* w_in; const float* b_in; const float* sinks; const float* w_out; const float* b_out; const float* ln_g; const float* ln_b;
              float* out; unsigned char* ws; };

__device__ __forceinline__ void p0_transpose_item(const float* W, int N, bf16_t* WT, bool perm, LAS float* scr, int item, int nblk, int lane) {
  const int kb = item / nblk, nb = item % nblk, k0 = 64 * kb, n0 = 32 * nb;
  const int nn = n0 + (lane & 31);
#pragma unroll 8
  for (int i = 0; i < 32; ++i) { const int kk = 2 * i + (lane >> 5); scr[kk * 33 + (lane & 31)] = nn < N ? W[(size_t)(k0 + kk) * N + nn] : 0.f; }
  LDSWAIT();
  const int c = lane & 7;
#pragma unroll
  for (int j = 0; j < 4; ++j) { const int n = (lane >> 3) + 8 * j; const LAS float* s = scr + (8 * c) * 33 + n;
    u32x4 o; o.x = cvt_pk_bf16(s[0 * 33], s[1 * 33]); o.y = cvt_pk_bf16(s[2 * 33], s[3 * 33]); o.z = cvt_pk_bf16(s[4 * 33], s[5 * 33]); o.w = cvt_pk_bf16(s[6 * 33], s[7 * 33]);
    const int grow = perm ? swap45(n0 + n) : (n0 + n);
    *(u32x4*)(WT + (size_t)grow * 1024 + k0 + 8 * c) = o; }
  LDSWAIT();
}
__device__ __forceinline__ void p0_prologue(const Args& a, LAS unsigned char* lds) {
  const int tid = threadIdx.x, lane = tid & 63, wid = tid >> 6;
  const int gw = blockIdx.x * NWAVES + wid, NGW = gridDim.x * NWAVES;
  LAS float* scr = (LAS float*)(lds + wid * 16384);
  bf16_t* BTIN = (bf16_t*)(a.ws + WS_BTIN); bf16_t* BTOUT = (bf16_t*)(a.ws + WS_BTOUT);
  constexpr int NBI = NPAD / 32, I_IN = 16 * NBI, I_OUT = 16 * 32;
  for (int it = gw; it < I_IN + I_OUT; it += NGW) {
    if (it < I_IN) p0_transpose_item(a.w_in, NCOL, BTIN, true, scr, it, NBI, lane);
    else p0_transpose_item(a.w_out, DM, BTOUT, false, scr, it - I_IN, 32, lane);
  }
  const int gt = blockIdx.x * NTHREADS + tid, NGT = gridDim.x * NTHREADS;
  bf16_t* XN = (bf16_t*)(a.ws + WS_XN);
  for (int i = gt; i < M * DM / 8; i += NGT) {
    const f32x4 v0 = *(const f32x4*)(a.x + (size_t)i * 8), v1 = *(const f32x4*)(a.x + (size_t)i * 8 + 4);
    u32x4 o; o.x = cvt_pk_bf16(v0[0], v0[1]); o.y = cvt_pk_bf16(v0[2], v0[3]); o.z = cvt_pk_bf16(v1[0], v1[1]); o.w = cvt_pk_bf16(v1[2], v1[3]);
    *(u32x4*)(XN + (size_t)i * 8) = o;
  }
  f32x2* CS = (f32x2*)(a.ws + WS_CS);
  for (int i = gt; i < M * 32; i += NGT) {
    const int row = i >> 5, j = i & 31;
    const float inv = exp2f(-(float)j * (13.287712379549449f / 32.0f));
    const float ang = (float)a.pos[row] * inv;
    CS[i] = (f32x2){cosf(ang), sinf(ang)};
  }
}

struct EpiInProj {
  static constexpr bool PERM = false, AFTER_DRAIN = false;
  bf16_t* H; float* IW; const float* bias; const f32x2* CS;
  __device__ __forceinline__ void operator()(const f32x4 (&acc)[2][2][4][2], const pg8::Unit& u, int wr, int wc, int fr, int fq) const {
    const int row0 = u.pm * 256 + wr * 64 + fr;
    const int dloc = 16 * (wc & 1) + 4 * fq;
#pragma unroll
    for (int bj = 0; bj < 2; ++bj) {
      const int G = 4 * u.pn + 2 * bj + (wc >> 1);
      if (G >= 44) continue;
      const int col1 = 64 * G + dloc;
      if (G == 43) {
        if (dloc == 0) {
          const f32x4 b1 = *(const f32x4*)(bias + col1);
#pragma unroll
          for (int ai = 0; ai < 2; ++ai)
#pragma unroll
            for (int m = 0; m < 4; ++m) { const int row = row0 + 128 * ai + 16 * m; *(f32x4*)(IW + (size_t)row * 4) = (acc[ai][bj][m][0] + b1) * 0.0625f; }
        }
        continue;
      }
      const f32x4 b1 = *(const f32x4*)(bias + col1), b2 = *(const f32x4*)(bias + col1 + 32);
      const bool rope = (G < 10) || (G >= 20 && G < 29) || (G >= 38);
      const bool silu = (G >= 12 && G < 20) || (G >= 30 && G < 38);
      const float sc = ((G < 8) || (G >= 20 && G < 28)) ? QSCALE : 1.0f;
#pragma unroll
      for (int ai = 0; ai < 2; ++ai)
#pragma unroll
        for (int m = 0; m < 4; ++m) {
          const int row = row0 + 128 * ai + 16 * m;
          f32x4 v1 = acc[ai][bj][m][0] + b1, v2 = acc[ai][bj][m][1] + b2;
          if (rope) {
            const f32x4 cs0 = *(const f32x4*)((const float*)CS + ((size_t)row * 32 + dloc) * 2), cs1 = *(const f32x4*)((const float*)CS + ((size_t)row * 32 + dloc) * 2 + 4);
            const f32x4 c = {cs0[0], cs0[2], cs1[0], cs1[2]}, s = {cs0[1], cs0[3], cs1[1], cs1[3]};
            const f32x4 o1 = v1 * c - v2 * s, o2 = v2 * c + v1 * s;
            v1 = o1 * sc; v2 = o2 * sc;
          } else if (silu) {
#pragma unroll
            for (int i = 0; i < 4; ++i) { v1[i] = v1[i] * __builtin_amdgcn_rcpf(1.0f + __builtin_amdgcn_exp2f(-LOG2E * v1[i])); v2[i] = v2[i] * __builtin_amdgcn_rcpf(1.0f + __builtin_amdgcn_exp2f(-LOG2E * v2[i])); }
          }
          u32x2 w1, w2; w1.x = cvt_pk_bf16(v1[0], v1[1]); w1.y = cvt_pk_bf16(v1[2], v1[3]); w2.x = cvt_pk_bf16(v2[0], v2[1]); w2.y = cvt_pk_bf16(v2[2], v2[3]);
          bf16_t* p = H + (size_t)row * HP + col1;
          *(u32x2*)p = w1; *(u32x2*)(p + 32) = w2;
        }
    }
  }
};
struct EpiOutProj {
  static constexpr bool PERM = false, AFTER_DRAIN = false;
  float* Y; const float* bias; const float* x;
  __device__ __forceinline__ void operator()(const f32x4 (&acc)[2][2][4][2], const pg8::Unit& u, int wr, int wc, int fr, int fq) const {
    const int row0 = u.pm * 256 + wr * 64 + fr, col0 = u.pn * 256 + wc * 32 + 4 * fq;
#pragma unroll
    for (int bj = 0; bj < 2; ++bj)
#pragma unroll
      for (int n = 0; n < 2; ++n) { const int col = col0 + 128 * bj + 16 * n; const f32x4 bv = *(const f32x4*)(bias + col);
#pragma unroll
        for (int ai = 0; ai < 2; ++ai)
#pragma unroll
          for (int m = 0; m < 4; ++m) { const size_t off = (size_t)(row0 + 128 * ai + 16 * m) * DM + col;
            *(f32x4*)(Y + off) = acc[ai][bj][m][n] + bv + ALPHA * *(const f32x4*)(x + off); } }
  }
};
__device__ __forceinline__ void swa_unit(LAS unsigned char* lds, int u, const bf16_t* H, const float* sinks, bf16_t* MIX) {
  const int tid = threadIdx.x, lane = tid & 63, wid = __builtin_amdgcn_readfirstlane(tid >> 6), r = lane & 31, h = lane >> 5;
  const int g = u & 1, qb = (u >> 1) & 127, b = u >> 8;
  const size_t rowbase = (size_t)b * SEQ;
  const int t00 = qb * 64, kbase = t00 - 128;
  for (int i = tid; i < 192 * 8; i += NTHREADS) {
    const int kl = i >> 3, piece = i & 7, key = kbase + kl;
    u32x4 v = {0u, 0u, 0u, 0u};
    if (key >= 0) v = *(const u32x4*)(H + (rowbase + key) * HP + C_AV + g * 64 + piece * 8);
    *(LAS u32x4*)(lds + kl * 128 + piece * 16) = v;
  }
  __syncthreads();
  const int r4 = wid & 3, sub = wid >> 2, hq = g * 4 + r4, t0 = t00 + 32 * sub;
  bf16x8 Bq[4];
#pragma unroll
  for (int ks = 0; ks < 4; ++ks) Bq[ks] = ldg16(H + (rowbase + t0 + r) * HP + C_AQ + hq * 64 + 16 * ks + 8 * h);
  f32x16 S[5];
#pragma unroll
  for (int tl = 0; tl < 5; ++tl) {
    const int key = t0 - 128 + 32 * tl + r, kc = key < 0 ? 0 : key;
    f32x16 acc;
#pragma unroll
    for (int i = 0; i < 16; ++i) acc[i] = 0.f;
#pragma unroll
    for (int ks = 0; ks < 4; ++ks) { const bf16x8 A = ldg16(H + (rowbase + kc) * HP + C_AK + g * 64 + 16 * ks + 8 * h); acc = MFMA32(A, Bq[ks], acc); }
    S[tl] = acc;
  }
  const float sk = sinks[hq] * LOG2E;
  float mx = sk;
#pragma unroll
  for (int tl = 0; tl < 5; ++tl)
#pragma unroll
    for (int i = 0; i < 16; ++i) {
      const int rel = r + 128 - 32 * tl - crow(i, h), key = t0 + r - rel;
      const bool valid = rel >= 0 && rel < 128 && key >= 0;
      S[tl][i] = valid ? S[tl][i] : -INFINITY;
      mx = fmaxf(mx, S[tl][i]);
    }
  mx = fmaxf(mx, __shfl_xor(mx, 32));
  float sum = 0.f;
#pragma unroll
  for (int tl = 0; tl < 5; ++tl)
#pragma unroll
    for (int i = 0; i < 16; ++i) { const float p = __builtin_amdgcn_exp2f(S[tl][i] - mx); S[tl][i] = p; sum += p; }
  sum += __shfl_xor(sum, 32);
  sum += __builtin_amdgcn_exp2f(sk - mx);
  const float rs = 1.0f / sum;
  f32x16 O[2];
#pragma unroll
  for (int dt = 0; dt < 2; ++dt)
#pragma unroll
    for (int i = 0; i < 16; ++i) O[dt][i] = 0.f;
  const int i16 = lane & 15, q4 = i16 >> 2, p4 = i16 & 3, g16 = (lane >> 4) & 1;
  LAS unsigned char* vb = lds + (32 * sub + 4 * h + q4) * 128 + (16 * g16 + 4 * p4) * 2;
#pragma unroll
  for (int tl = 0; tl < 5; ++tl)
#pragma unroll
    for (int s = 0; s < 2; ++s) {
      const bf16x8 P = pack8(S[tl], s);
#pragma unroll
      for (int dt = 0; dt < 2; ++dt) {
        LAS unsigned char* p = vb + (32 * tl + 16 * s) * 128 + dt * 64;
        const s16x4 lo = tr_read(p), hi = tr_read(p + 8 * 128);
        const bf16x8 A2 = __builtin_shufflevector(lo, hi, 0, 1, 2, 3, 4, 5, 6, 7);
        O[dt] = MFMA32(A2, P, O[dt]);
      }
    }
  const size_t row = rowbase + t0 + r;
#pragma unroll
  for (int dt = 0; dt < 2; ++dt)
#pragma unroll
    for (int g4 = 0; g4 < 4; ++g4) {
      const int d = 32 * dt + 8 * g4 + 4 * h;
      const u32x2 gt = *(const u32x2*)(H + row * HP + C_AG + hq * 64 + d);
      const float o0 = O[dt][4 * g4 + 0] * rs * __uint_as_float(gt.x << 16), o1 = O[dt][4 * g4 + 1] * rs * __uint_as_float(gt.x & 0xffff0000u);
      const float o2 = O[dt][4 * g4 + 2] * rs * __uint_as_float(gt.y << 16), o3 = O[dt][4 * g4 + 3] * rs * __uint_as_float(gt.y & 0xffff0000u);
      u32x2 w; w.x = cvt_pk_bf16(o0, o1); w.y = cvt_pk_bf16(o2, o3);
      *(u32x2*)(MIX + row * DM + hq * 64 + d) = w;
    }
  __syncthreads();
}

constexpr int IH_H2 = 0, IH_BMA = 16384, IH_BMT = 49152, IH_SCR = 81920, IH_WL = 131072, IH_TC = 131584, IH_KK = 131712, IH_TLO = 131840, IH_TUP = 131968, IH_M = 132096;
constexpr int L_UNIT = LDS_BYTES - 256, L_BAR = LDS_BYTES - 128;
static_assert(IH_SCR + 8 * 4608 <= IH_WL && IH_M + 128 <= L_UNIT && 131072 + 8 * 1024 <= L_UNIT, "LDS map");
__device__ __forceinline__ unsigned okey(float s) { unsigned ub = __float_as_uint(s); ub = (ub & 0x7fffffffu) ? ub : 0u; return ub ^ ((unsigned)((int)ub >> 31) | 0x80000000u); }
__device__ __forceinline__ float okey_inv(unsigned k) { return __uint_as_float((k & 0x80000000u) ? (k ^ 0x80000000u) : ~k); }
template <int NW_>
__device__ __forceinline__ void hist_find(const unsigned (&w)[NW_], unsigned kk, int lane, unsigned& bin, unsigned& above, unsigned& total) {
  unsigned s = 0u;
#pragma unroll
  for (int i = 0; i < NW_; ++i) s += (w[i] & 0xffffu) + (w[i] >> 16);
  unsigned incl = s;
#pragma unroll
  for (int o = 1; o < 64; o <<= 1) { const unsigned t = __shfl_down(incl, o); if (lane + o < 64) incl += t; }
  total = (unsigned)__builtin_amdgcn_readfirstlane((int)incl);
  unsigned run = incl - s; bool found = false; unsigned bl = 0u, al = 0u;
#pragma unroll
  for (int i = NW_ - 1; i >= 0; --i) {
    const unsigned chi = w[i] >> 16, clo = w[i] & 0xffffu;
    if (!found && run < kk && run + chi >= kk) { found = true; bl = (unsigned)(2 * NW_) * lane + 2 * i + 1; al = run; } run += chi;
    if (!found && run < kk && run + clo >= kk) { found = true; bl = (unsigned)(2 * NW_) * lane + 2 * i; al = run; } run += clo;
  }
  const unsigned long long fm = __ballot(found);
  const int src = fm ? (__ffsll((long long)fm) - 1) : 0;
  bin = (unsigned)__builtin_amdgcn_readlane((int)bl, src); above = (unsigned)__builtin_amdgcn_readlane((int)al, src);
}

__device__ __forceinline__ void indexer_unit(LAS unsigned char* lds, int u, const bf16_t* H, const float* IW, unsigned short* SEL, int* NSEL) {
  const int tid = threadIdx.x, lane = tid & 63, wid = __builtin_amdgcn_readfirstlane(tid >> 6), r = lane & 31, h = lane >> 5;
  const int b = u & 1, qblk = 255 - (u >> 1);
  LAS float* scr = (LAS float*)(lds + IH_SCR + wid * 4608);
  LAS float* wl = (LAS float*)(lds + IH_WL);
  LAS unsigned* TC = (LAS unsigned*)(lds + IH_TC); LAS unsigned* KK = (LAS unsigned*)(lds + IH_KK); LAS unsigned* MM = (LAS unsigned*)(lds + IH_M);
  LAS float* TLO = (LAS float*)(lds + IH_TLO); LAS float* TUP = (LAS float*)(lds + IH_TUP);
  const int q0 = qblk * 32; const size_t rowbase = (size_t)b * SEQ;
#pragma unroll
  for (int i = 0; i < 16; ++i) *(LAS u32x4*)(lds + (i * NTHREADS + tid) * 16) = (u32x4){0u, 0u, 0u, 0u};
  if (tid < 32) *(LAS f32x4*)(wl + tid * 4) = *(const f32x4*)(IW + (rowbase + q0 + tid) * 4);
  bf16x8 Aq[4][4];
#pragma unroll
  for (int rt = 0; rt < 4; ++rt)
#pragma unroll
    for (int ks = 0; ks < 4; ++ks) Aq[rt][ks] = ldg16(H + (rowbase + q0 + 8 * rt + (r >> 2)) * HP + C_IQ + (r & 3) * 64 + 16 * ks + 8 * h);
  __syncthreads();
  const int nch = (q0 + 32 + 255) >> 8;
#define IDX_PASS(ACTION, AFTER_TILE) do { \
    bf16x8 Bk[4]; \
    _Pragma("unroll") for (int ks = 0; ks < 4; ++ks) Bk[ks] = ldg16(H + (rowbase + wid * 32 + r) * HP + C_IK + 16 * ks + 8 * h); \
    for (int c = 0; c < nch; ++c) { \
      const int kt0 = c * 256 + wid * 32; \
      bf16x8 Bn[4]; \
      _Pragma("unroll") for (int ks = 0; ks < 4; ++ks) Bn[ks] = Bk[ks]; \
      if (c + 1 < nch) { _Pragma("unroll") for (int ks = 0; ks < 4; ++ks) Bn[ks] = ldg16(H + (rowbase + kt0 + 256 + r) * HP + C_IK + 16 * ks + 8 * h); } \
      if (kt0 <= q0 + 31) { \
        const int key = kt0 + r; \
        _Pragma("unroll") for (int rt = 0; rt < 4; ++rt) { \
          f32x16 acc; \
          _Pragma("unroll") for (int i = 0; i < 16; ++i) acc[i] = 0.f; \
          _Pragma("unroll") for (int ks = 0; ks < 4; ++ks) acc = MFMA32(Aq[rt][ks], Bk[ks], acc); \
          _Pragma("unroll") for (int g = 0; g < 4; ++g) { \
            const int ql = 8 * rt + 2 * g + h; \
            const f32x4 w = *(LAS f32x4*)(wl + ql * 4); \
            float s = w[0] * relu1(acc[4 * g]); \
            s = __builtin_fmaf(w[1], relu1(acc[4 * g + 1]), s); s = __builtin_fmaf(w[2], relu1(acc[4 * g + 2]), s); s = __builtin_fmaf(w[3], relu1(acc[4 * g + 3]), s); \
            ACTION } } \
        AFTER_TILE } \
      _Pragma("unroll") for (int ks = 0; ks < 4; ++ks) Bk[ks] = Bn[ks]; } } while (0)

#define ACT1 { const unsigned cb = okey(s) >> 21; if (key <= q0 + ql) __hip_atomic_fetch_add((LAS unsigned*)(lds + ql * 4096) + (cb >> 1), 1u << ((cb & 1u) * 16u), __ATOMIC_RELAXED, __HIP_MEMORY_SCOPE_WORKGROUP); }
  IDX_PASS(ACT1, ;);
#undef ACT1
  __syncthreads();
  for (int qq = wid; qq < 32; qq += 8) {
    unsigned w[16];
#pragma unroll
    for (int i = 0; i < 4; ++i) { const u32x4 t = *(LAS u32x4*)(lds + qq * 4096 + lane * 64 + i * 16); w[4 * i] = t.x; w[4 * i + 1] = t.y; w[4 * i + 2] = t.z; w[4 * i + 3] = t.w; }
    unsigned bin, above, total; hist_find<16>(w, 256u, lane, bin, above, total);
    if (lane == 0) { if (total <= 256u) { TC[qq] = 0xffffffffu; KK[qq] = 0u; } else { TC[qq] = bin; KK[qq] = 256u - above; } }
  }
  __syncthreads();
#pragma unroll
  for (int i = 0; i < 10; ++i) *(LAS u32x4*)(lds + (i * NTHREADS + tid) * 16) = (u32x4){0u, 0u, 0u, 0u};
  unsigned tcs[4][4];
#pragma unroll
  for (int rt = 0; rt < 4; ++rt)
#pragma unroll
    for (int g = 0; g < 4; ++g) tcs[rt][g] = TC[8 * rt + 2 * g + h];
  __syncthreads();
#define ACT2 { const unsigned k = okey(s); if (key <= q0 + ql && (k >> 21) == tcs[rt][g]) { const unsigned sb = (k >> 13) & 255u; \
      __hip_atomic_fetch_add((LAS unsigned*)(lds + IH_H2 + ql * 512) + (sb >> 1), 1u << ((sb & 1u) * 16u), __ATOMIC_RELAXED, __HIP_MEMORY_SCOPE_WORKGROUP); } }
  IDX_PASS(ACT2, ;);
#undef ACT2
  __syncthreads();
  for (int qq = wid; qq < 32; qq += 8) {
    const unsigned tc = TC[qq], kk = KK[qq];
    if (tc == 0xffffffffu) { if (lane == 0) { TLO[qq] = -INFINITY; TUP[qq] = -INFINITY; MM[qq] = 0u; } }
    else {
      unsigned w[2]; { const u32x2 t = *(LAS u32x2*)(lds + IH_H2 + qq * 512 + lane * 8); w[0] = t.x; w[1] = t.y; }
      unsigned bin, above, total; hist_find<2>(w, kk, lane, bin, above, total);
      const unsigned t19 = (tc << 8) | bin;
      if (lane == 0) { TLO[qq] = okey_inv(t19 << 13); TUP[qq] = okey_inv((t19 << 13) | 0x1fffu); MM[qq] = kk - above; }
    }
  }
  __syncthreads();
  {
    const int myq = lane & 31, mykh = lane >> 5;
    const float tlo = TLO[myq], tup = TUP[myq];
    LAS unsigned short* bma = (LAS unsigned short*)(lds + IH_BMA + myq * 1024);
    LAS unsigned short* bmt = (LAS unsigned short*)(lds + IH_BMT + myq * 1024);
#define ACT3 { scr[ql * 36 + r] = s; }
#define AFT3 { LDSWAIT(); \
      f32x4 e[4]; \
      _Pragma("unroll") for (int i = 0; i < 4; ++i) e[i] = *(LAS f32x4*)(scr + myq * 36 + mykh * 16 + 4 * i); \
      unsigned mg = 0u, me = 0u; \
      _Pragma("unroll") for (int i = 3; i >= 0; --i) _Pragma("unroll") for (int j = 3; j >= 0; --j) { \
        asm volatile("v_cmp_gt_f32 vcc, %1, %2\n\tv_addc_co_u32 %0, vcc, %0, %0, vcc" : "+v"(mg) : "v"(e[i][j]), "v"(tup) : "vcc"); \
        asm volatile("v_cmp_ge_f32 vcc, %1, %2\n\tv_addc_co_u32 %0, vcc, %0, %0, vcc" : "+v"(me) : "v"(e[i][j]), "v"(tlo) : "vcc"); } \
      int nv = q0 + myq - (kt0 + 16 * mykh) + 1; nv = nv < 0 ? 0 : (nv > 16 ? 16 : nv); \
      const unsigned vm = (1u << nv) - 1u; \
      mg &= vm; me &= vm & ~mg; \
      const int hw = (kt0 >> 4) + mykh; \
      bma[hw] = (unsigned short)mg; bmt[hw] = (unsigned short)me; \
      LDSWAIT(); }
    IDX_PASS(ACT3, AFT3);
#undef ACT3
#undef AFT3
  }
  __syncthreads();
  for (int qq = wid; qq < 32; qq += 8) {
    const size_t row = rowbase + q0 + qq; const unsigned m = MM[qq];
    const u32x4 av = *(LAS u32x4*)(lds + IH_BMA + qq * 1024 + lane * 16), tv = *(LAS u32x4*)(lds + IH_BMT + qq * 1024 + lane * 16);
    unsigned tw[4] = {tv.x, tv.y, tv.z, tv.w}; const unsigned aw[4] = {av.x, av.y, av.z, av.w};
    const unsigned tcl = (unsigned)(__popc(tw[0]) + __popc(tw[1]) + __popc(tw[2]) + __popc(tw[3]));
    unsigned tincl = tcl;
#pragma unroll
    for (int o = 1; o < 64; o <<= 1) { const unsigned t = __shfl_up(tincl, o); if (lane >= o) tincl += t; }
    unsigned run = tincl - tcl;
#pragma unroll
    for (int i = 0; i < 4; ++i) {
      const unsigned c = (unsigned)__popc(tw[i]);
      if (run >= m) tw[i] = 0u;
      else if (run + c > m) { const unsigned need = m - run; while ((unsigned)__popc(tw[i]) > need) tw[i] &= ~(1u << (31 - __clz((int)tw[i]))); }
      run += c;
    }
    unsigned sw[4]; unsigned scl = 0u;
#pragma unroll
    for (int i = 0; i < 4; ++i) { sw[i] = aw[i] | tw[i]; scl += (unsigned)__popc(sw[i]); }
    unsigned sincl = scl;
#pragma unroll
    for (int o = 1; o < 64; o <<= 1) { const unsigned t = __shfl_up(sincl, o); if (lane >= o) sincl += t; }
    unsigned pos = sincl - scl;
    const unsigned total = (unsigned)__builtin_amdgcn_readlane((int)sincl, 63);
#pragma unroll
    for (int i = 0; i < 4; ++i) { unsigned x = sw[i]; while (x) { const int bb = __ffs((int)x) - 1; x &= x - 1u; if (pos < 256u) SEL[row * 256 + pos] = (unsigned short)(lane * 128 + i * 32 + bb); ++pos; } }
    if (lane == 0) NSEL[row] = (int)(total > 256u ? 256u : total);
  }
#undef IDX_PASS
  __syncthreads();
}

__device__ __forceinline__ void sparse_attn_phase(LAS unsigned char* lds, const bf16_t* H, const unsigned short* SEL, const int* NSEL, bf16_t* MIX) {
  const int tid = threadIdx.x, lane = tid & 63, wid = __builtin_amdgcn_readfirstlane(tid >> 6), r = lane & 31, h = lane >> 5;
  const int gw = blockIdx.x * NWAVES + wid, NGW = gridDim.x * NWAVES;
  LAS unsigned char* vbuf = lds + wid * 16384;
  LAS unsigned char* selb = lds + 131072 + wid * 1024;
  const int i16 = lane & 15, q4 = i16 >> 2, p4 = i16 & 3, g16 = (lane >> 4) & 1;
  const unsigned troff = (4 * h + q4) * 128 + (16 * g16 + 4 * p4) * 2;
  const int hk_off = C_BK + 8 * h, hv_off = C_BV + (lane & 7) * 8;
#define SP_LOAD(A, V, tl, qi) do { \
    const int kidx_ = (int)*(LAS unsigned short*)(selb + (qi) * 512 + 2 * (32 * (tl) + r)); \
    _Pragma("unroll") for (int ks = 0; ks < 4; ++ks) A[ks] = ldg16(H + ((rowbase + kidx_) * HP + hk_off + 16 * ks)); \
    _Pragma("unroll") for (int i = 0; i < 4; ++i) { const int kiv_ = (int)*(LAS unsigned short*)(selb + (qi) * 512 + 2 * (32 * (tl) + (lane >> 3) + 8 * i)); \
      V[i] = *(const u32x4*)(H + ((rowbase + kiv_) * HP + hv_off)); } } while (0)
#define SP_COMPUTE(A, V, tl, qi, Bq, O, mx, sum, n) do { \
    LAS unsigned char* vb = vbuf + (qi) * 8192 + ((tl) & 1) * 4096; \
    f32x16 S; \
    _Pragma("unroll") for (int i = 0; i < 16; ++i) S[i] = 0.f; \
    _Pragma("unroll") for (int ks = 0; ks < 4; ++ks) S = MFMA32(A[ks], Bq[ks], S); \
    _Pragma("unroll") for (int i = 0; i < 4; ++i) *(LAS u32x4*)(vb + ((lane >> 3) + 8 * i) * 128 + (lane & 7) * 16) = V[i]; \
    float tm = -INFINITY; \
    _Pragma("unroll") for (int i = 0; i < 16; ++i) { const bool valid = 32 * (tl) + crow(i, h) < n; S[i] = valid ? S[i] : -INFINITY; tm = fmaxf(tm, S[i]); } \
    tm = fmaxf(tm, __shfl_xor(tm, 32)); \
    const float mn = fmaxf(mx, tm), corr = exp2f(mx - mn); \
    mx = mn; \
    float ps = 0.f; \
    _Pragma("unroll") for (int i = 0; i < 16; ++i) { const float p = exp2f(S[i] - mn); S[i] = p; ps += p; } \
    sum = sum * corr + ps; \
    _Pragma("unroll") for (int dt = 0; dt < 2; ++dt) _Pragma("unroll") for (int i = 0; i < 16; ++i) O[dt][i] *= corr; \
    LDSWAIT(); \
    _Pragma("unroll") for (int s = 0; s < 2; ++s) { \
      const bf16x8 P = pack8(S, s); \
      _Pragma("unroll") for (int dt = 0; dt < 2; ++dt) { \
        LAS unsigned char* p = vb + troff + (16 * s) * 128 + dt * 64; \
        const s16x4 lo = tr_read(p), hi = tr_read(p + 8 * 128); \
        const bf16x8 A2 = __builtin_shufflevector(lo, hi, 0, 1, 2, 3, 4, 5, 6, 7); \
        O[dt] = MFMA32(A2, P, O[dt]); } } } while (0)
#define SP_STORE(row, O, sum) do { \
    const float tot_ = sum + __shfl_xor(sum, 32); const float rs = 1.0f / tot_; \
    if (r < 8) { \
      _Pragma("unroll") for (int dt = 0; dt < 2; ++dt) _Pragma("unroll") for (int g4 = 0; g4 < 4; ++g4) { \
          const int d = 32 * dt + 8 * g4 + 4 * h; \
          const u32x2 gt = *(const u32x2*)(H + (size_t)(row) * HP + C_BG + r * 64 + d); \
          const float o0 = O[dt][4 * g4 + 0] * rs * __uint_as_float(gt.x << 16), o1 = O[dt][4 * g4 + 1] * rs * __uint_as_float(gt.x & 0xffff0000u); \
          const float o2 = O[dt][4 * g4 + 2] * rs * __uint_as_float(gt.y << 16), o3 = O[dt][4 * g4 + 3] * rs * __uint_as_float(gt.y & 0xffff0000u); \
          u32x2 w; w.x = cvt_pk_bf16(o0, o1); w.y = cvt_pk_bf16(o2, o3); \
          *(u32x2*)(MIX + (size_t)(row) * DM + 512 + r * 64 + d) = w; } } } while (0)
  for (int pr = gw; pr < M / 2; pr += NGW) {
    const int row0 = 2 * pr, row1 = row0 + 1;
    const int rowbase = (row0 >> 13) * SEQ;
    const int n0 = __builtin_amdgcn_readfirstlane(NSEL[row0]), n1 = __builtin_amdgcn_readfirstlane(NSEL[row1]);
    { u32x2 s0 = *(const u32x2*)(SEL + (size_t)row0 * 256 + lane * 4), s1 = *(const u32x2*)(SEL + (size_t)row1 * 256 + lane * 4);
      const int sl = 4 * lane;
      s0.x &= (sl + 1 < n0 ? 0xffffffffu : (sl < n0 ? 0xffffu : 0u)); s0.y &= (sl + 3 < n0 ? 0xffffffffu : (sl + 2 < n0 ? 0xffffu : 0u));
      s1.x &= (sl + 1 < n1 ? 0xffffffffu : (sl < n1 ? 0xffffu : 0u)); s1.y &= (sl + 3 < n1 ? 0xffffffffu : (sl + 2 < n1 ? 0xffffu : 0u));
      *(LAS u32x2*)(selb + lane * 8) = s0; *(LAS u32x2*)(selb + 512 + lane * 8) = s1; }
    bf16x8 Bq0[4], Bq1[4];
#pragma unroll
    for (int ks = 0; ks < 4; ++ks) {
      bf16x8 v0 = ldg16(H + (size_t)row0 * HP + C_BQ + (r & 7) * 64 + 16 * ks + 8 * h), v1 = ldg16(H + (size_t)row1 * HP + C_BQ + (r & 7) * 64 + 16 * ks + 8 * h);
      if (r >= 8) { v0 = (bf16x8){0, 0, 0, 0, 0, 0, 0, 0}; v1 = v0; }
      Bq0[ks] = v0; Bq1[ks] = v1; }
    f32x16 O0[2], O1[2];
#pragma unroll
    for (int dt = 0; dt < 2; ++dt)
#pragma unroll
      for (int i = 0; i < 16; ++i) { O0[dt][i] = 0.f; O1[dt][i] = 0.f; }
    float mx0 = -INFINITY, sum0 = 0.f, mx1 = -INFINITY, sum1 = 0.f;
    LDSWAIT();
    bf16x8 A0[4], A1[4]; u32x4 V0[4], V1[4];
    SP_LOAD(A0, V0, 0, 0);
#pragma unroll 1
    for (int tl = 0; tl < 8; ++tl) {
      SP_LOAD(A1, V1, tl, 1);
      SP_COMPUTE(A0, V0, tl, 0, Bq0, O0, mx0, sum0, n0);
      const int tn = tl < 7 ? tl + 1 : 7;
      SP_LOAD(A0, V0, tn, 0);
      SP_COMPUTE(A1, V1, tl, 1, Bq1, O1, mx1, sum1, n1);
    }
    SP_STORE(row0, O0, sum0);
    SP_STORE(row1, O1, sum1);
    LDSWAIT();
  }
#undef SP_LOAD
#undef SP_COMPUTE
#undef SP_STORE
}

__device__ __forceinline__ float wave_sum(float v) {
#pragma unroll
  for (int o = 1; o < 64; o <<= 1) v += __shfl_xor(v, o);
  return v;
}
__device__ __forceinline__ void ln_phase(const float* Y, const float* g, const float* bta, float* out) {
  const int tid = threadIdx.x, lane = tid & 63, wid = tid >> 6;
  const int gw = blockIdx.x * NWAVES + wid, NGW = gridDim.x * NWAVES;
  f32x4 gv[4], bv[4];
#pragma unroll
  for (int j = 0; j < 4; ++j) { gv[j] = *(const f32x4*)(g + 4 * lane + 256 * j); bv[j] = *(const f32x4*)(bta + 4 * lane + 256 * j); }
  for (int row = gw; row < M; row += NGW) {
    const f32x4* yr = (const f32x4*)(Y + (size_t)row * DM) + lane;
    f32x4 v[4]; float s = 0.f;
#pragma unroll
    for (int j = 0; j < 4; ++j) { v[j] = yr[64 * j]; s += (v[j][0] + v[j][1]) + (v[j][2] + v[j][3]); }
    const float mean = wave_sum(s) * (1.f / DM); float s2 = 0.f;
#pragma unroll
    for (int j = 0; j < 4; ++j) { v[j] = v[j] - mean; s2 += (v[j][0] * v[j][0] + v[j][1] * v[j][1]) + (v[j][2] * v[j][2] + v[j][3] * v[j][3]); }
    const float rstd = 1.f / sqrtf(wave_sum(s2) * (1.f / DM) + LN_EPS);
    f32x4* o = (f32x4*)(out + (size_t)row * DM) + lane;
#pragma unroll
    for (int j = 0; j < 4; ++j) o[64 * j] = v[j] * rstd * gv[j] + bv[j];
  }
}

#define XB_TMO      128
#define XB_XCNT(j)  (256  + 64 * (j))
#define XB_XSUB(j)  (1280 + 64 * (j))
#define XB_XGEN(j)  (2304 + 64 * (j))
#define XB_TOP      3328
#define XB_TOPGEN   3392
#define XCD_BAR_WORDS 3456
#define XB_SPIN_CAP (1u << 18)

__device__ __forceinline__ unsigned xb_ld(unsigned* p)              { return __hip_atomic_load(p, __ATOMIC_RELAXED, __HIP_MEMORY_SCOPE_AGENT); }
__device__ __forceinline__ unsigned xb_add(unsigned* p, unsigned v) { return __hip_atomic_fetch_add(p, v, __ATOMIC_RELAXED, __HIP_MEMORY_SCOPE_AGENT); }
__device__ __forceinline__ unsigned xb_xcc_id() { return (unsigned)__builtin_amdgcn_s_getreg((3 << 11) | 20) & 0xFu; }
#define XB_SPIN(cond, bar) do { unsigned _sp = 0; while (cond) { __builtin_amdgcn_s_sleep(1); \
    if ((++_sp & 255u) == 0u) { if (xb_ld(&(bar)[XB_TMO])) break; if (_sp > XB_SPIN_CAP) { atomicAdd(&(bar)[XB_TMO], 1u); break; } } } } while (0)

struct XcdBarrier {
    unsigned* bar; unsigned x;
    volatile LAS unsigned* st;
};

__device__ __forceinline__ XcdBarrier xcd_barrier_post(unsigned* bar, volatile LAS unsigned* st) {
    XcdBarrier b; b.bar = bar; b.x = xb_xcc_id(); b.st = st;
    if (threadIdx.x == 0) (void)xb_add(&bar[XB_XCNT(b.x)], 1u);
    return b;
}
__device__ __forceinline__ void xcd_barrier_complete(unsigned* bar, unsigned x, unsigned& nloc, unsigned& nx) {
    const unsigned G = gridDim.x * gridDim.y * gridDim.z;
    unsigned sum, cnt, mine, sp = 0u;
    for (;;) {
        sum = 0u; cnt = 0u; mine = 0u;
#pragma unroll
        for (unsigned j = 0; j < 16; ++j) { const unsigned c = xb_ld(&bar[XB_XCNT(j)]); sum += c; cnt += (c > 0u) ? 1u : 0u; mine = (j == x) ? c : mine; }
        if (sum == G) break;
        __builtin_amdgcn_s_sleep(1);
        if ((++sp & 255u) == 0u) { if (xb_ld(&bar[XB_TMO])) break; if (sp > XB_SPIN_CAP) { atomicAdd(&bar[XB_TMO], 1u); break; } }
    }
    nloc = mine > 0u ? mine : 1u; nx = cnt > 0u ? cnt : 1u;
}

__device__ __forceinline__ void xcd_barrier(const XcdBarrier& b) {
    asm volatile("s_waitcnt vmcnt(0)" ::: "memory");
    __syncthreads();
    if (threadIdx.x == 0) {
        unsigned* bar = b.bar;
        __builtin_amdgcn_s_waitcnt(0);
        unsigned nloc = b.st[0], nx = b.st[1];
        if (nloc == 0u) { xcd_barrier_complete(bar, b.x, nloc, nx); b.st[0] = nloc; b.st[1] = nx; }
        const unsigned old = xb_add(&bar[XB_XSUB(b.x)], 1u);
        const unsigned gen = old / nloc;
        if (old + 1u == (gen + 1u) * nloc) {
            __builtin_amdgcn_fence(__ATOMIC_RELEASE, "agent");
            asm volatile("s_waitcnt vmcnt(0)" ::: "memory");
            const unsigned og = xb_add(&bar[XB_TOP], 1u);
            const unsigned tg = og / nx;
            if (og + 1u == (tg + 1u) * nx) xb_add(&bar[XB_TOPGEN], 1u);
            else XB_SPIN(xb_ld(&bar[XB_TOPGEN]) == tg, bar);
            __builtin_amdgcn_fence(__ATOMIC_ACQUIRE, "agent");
            xb_add(&bar[XB_XGEN(b.x)], 1u);
            asm volatile("s_waitcnt vmcnt(0)" ::: "memory");
        } else {
            XB_SPIN(xb_ld(&bar[XB_XGEN(b.x)]) == gen, bar);
            __builtin_amdgcn_fence(__ATOMIC_ACQUIRE, "agent");
            asm volatile("s_waitcnt vmcnt(0)" ::: "memory");
        }
    }
    __syncthreads();
}

#ifndef PHMASK
#define PHMASK 255
#endif
#ifndef REPMASK
#define REPMASK 0
#endif
__global__ void __launch_bounds__(NTHREADS, 2) hybrid_fwd(Args a) {
  extern __shared__ __attribute__((aligned(16))) unsigned char lds_raw[];
  LAS unsigned char* lds = (LAS unsigned char*)lds_raw;
  cg::grid_group grid = cg::this_grid();
  const int tid = threadIdx.x;
  if (a.ws == nullptr) grid.sync();
  bf16_t* BTIN = (bf16_t*)(a.ws + WS_BTIN); bf16_t* BTOUT = (bf16_t*)(a.ws + WS_BTOUT);
  bf16_t* XN = (bf16_t*)(a.ws + WS_XN); bf16_t* H = (bf16_t*)(a.ws + WS_H); bf16_t* MIX = (bf16_t*)(a.ws + WS_MIX);
  float* IW = (float*)(a.ws + WS_IW); float* YPRE = (float*)(a.ws + WS_YPRE);
  int* NSEL = (int*)(a.ws + WS_NSEL); unsigned short* SEL = (unsigned short*)(a.ws + WS_SEL);
  unsigned* ctl = (unsigned*)(a.ws + WS_CTL);
  volatile LAS unsigned* bst = (volatile LAS unsigned*)(lds + L_BAR);
  if (tid < 2) bst[tid] = 0u;
  __syncthreads();
  const XcdBarrier bar = xcd_barrier_post(ctl + 1024, bst);
  if (PHMASK & 1) for (int rep = 0; rep < ((REPMASK & 1) ? 2 : 1); ++rep) p0_prologue(a, lds);
  xcd_barrier(bar);
  if (PHMASK & 2) {
    pg8::Gemm g{XN, BTIN, M, NPAD, DM}; pg8::StaticOrder S; S.init(M, NPAD, (int)gridDim.x, (int)blockIdx.x);
    EpiInProj E{H, IW, a.b_in, (const f32x2*)(a.ws + WS_CS)};
    pg8::gemm_phase<EpiInProj, pg8::StaticOrder, true, true>(lds, g, S, E);
  }
  if (REPMASK & 2) {
    pg8::Gemm g{XN, BTIN, M, NPAD, DM}; pg8::StaticOrder S; S.init(M, NPAD, (int)gridDim.x, (int)blockIdx.x);
    EpiInProj E{H, IW, a.b_in, (const f32x2*)(a.ws + WS_CS)};
    pg8::gemm_phase<EpiInProj, pg8::StaticOrder, true, true>(lds, g, S, E);
  }
  xcd_barrier(bar);
  if (PHMASK & 4) {
    LAS int* us = (LAS int*)(lds + L_UNIT);
    if (PHMASK & 64) for (int rep = 0; rep < ((REPMASK & 64) ? 2 : 1); ++rep) for (;;) {
      if (tid == 0) *us = (int)__hip_atomic_fetch_add(ctl + 128 * rep, 1u, __ATOMIC_RELAXED, __HIP_MEMORY_SCOPE_AGENT);
      __syncthreads();
      const int u = *us;
      __syncthreads();
      if (u >= 512) break;
      indexer_unit(lds, u, H, IW, SEL, NSEL);
    }
    if (PHMASK & 128) for (int rep = 0; rep < ((REPMASK & 128) ? 2 : 1); ++rep) for (;;) {
      if (tid == 0) *us = (int)__hip_atomic_fetch_add(ctl + 64 + 128 * rep, 1u, __ATOMIC_RELAXED, __HIP_MEMORY_SCOPE_AGENT);
      __syncthreads();
      const int u = *us;
      __syncthreads();
      if (u >= 512) break;
      swa_unit(lds, u, H, a.sinks, MIX);
    }
  }
  xcd_barrier(bar);
  if (PHMASK & 8) for (int rep = 0; rep < ((REPMASK & 8) ? 2 : 1); ++rep) sparse_attn_phase(lds, H, SEL, NSEL, MIX);
  xcd_barrier(bar);
  if (PHMASK & 16) for (int rep = 0; rep < ((REPMASK & 16) ? 2 : 1); ++rep) {
    pg8::Gemm g{MIX, BTOUT, M, DM, DM}; pg8::StaticOrder S; S.init(M, DM, (int)gridDim.x, (int)blockIdx.x);
    EpiOutProj E{YPRE, a.b_out, a.x};
    pg8::gemm_phase<EpiOutProj, pg8::StaticOrder, true, true>(lds, g, S, E);
  }
  xcd_barrier(bar);
  if (PHMASK & 32) for (int rep = 0; rep < ((REPMASK & 32) ? 2 : 1); ++rep) ln_phase(YPRE, a.ln_g, a.ln_b, a.out);
}

extern "C" void kernel_launch(void* const* d_in, const int* in_sizes, int n_in, void* d_out, int out_size, void* d_ws, size_t ws_size, hipStream_t stream) {
  static int grid = 0;
  if (grid == 0) {
    if (n_in != 9 || ws_size < WS_END) { fprintf(stderr, "kernel_launch: unexpected inputs (n_in %d, ws %zu)\n", n_in, ws_size); grid = -1; return; }
    int dev = 0, cus = 0, per_cu = 0;
    (void)hipGetDevice(&dev); (void)hipDeviceGetAttribute(&cus, hipDeviceAttributeMultiprocessorCount, dev);
    if (hipFuncSetAttribute((const void*)hybrid_fwd, hipFuncAttributeMaxDynamicSharedMemorySize, LDS_BYTES) != hipSuccess) { fprintf(stderr, "kernel_launch: hipFuncSetAttribute failed\n"); grid = -1; return; }
    (void)hipOccupancyMaxActiveBlocksPerMultiprocessor(&per_cu, (const void*)hybrid_fwd, NTHREADS, LDS_BYTES);
    if (per_cu < 1) { fprintf(stderr, "kernel_launch: occupancy query says %d blocks per CU\n", per_cu); per_cu = 1; }
    (void)hipGetLastError();
    grid = cus;
  }
  if (grid < 0) return;
  (void)hipMemsetAsync((char*)d_ws + WS_CTL, 0, 32768, stream);
  Args a{};
  a.x = (const float*)d_in[0]; a.pos = (const int*)d_in[1]; a.w_in = (const float*)d_in[2]; a.b_in = (const float*)d_in[3]; a.sinks = (const float*)d_in[4];
  a.w_out = (const float*)d_in[5]; a.b_out = (const float*)d_in[6]; a.ln_g = (const float*)d_in[7]; a.ln_b = (const float*)d_in[8];
  a.out = (float*)d_out; a.ws = (unsigned char*)d_ws;
  void* args[] = {&a};
  hipError_t e = hipLaunchCooperativeKernel((const void*)hybrid_fwd, dim3(grid), dim3(NTHREADS), args, LDS_BYTES, stream);
  if (e != hipSuccess) fprintf(stderr, "kernel_launch: cooperative launch failed: %s (grid %d)\n", hipGetErrorString(e), grid);
}
```
